# Optimizing an MI355X kernel written in HIP

```python
import jax, jax.numpy as jnp
from jax import lax
import numpy as np

D_MODEL = 4096
BATCH = 2
SEQ = 4096
DEPTH = 2

HEAD_DIM = D_MODEL // 32
ROPE_THETA = 10000.0
EPS = 1e-6
NEG = -1e30
NSA_HEADS = 12
NSA_KV_HEADS = 2
NSA_GROUP = NSA_HEADS // NSA_KV_HEADS
NSA_BLOCK = 64
NSA_TOPN = 16
NSA_WINDOW = 512
NSA_Q_BLOCK = 64
NSA_CMP_HIDDEN = 256
NSA_FORCED_SCORE = NSA_GROUP + 1.0
DIL_PAIRS = ((128, 1), (512, 4), (2048, 16))
DIL_HEADS_PER_PAIR = 4
DIL_HEADS = DIL_HEADS_PER_PAIR * len(DIL_PAIRS)
DIL_Q_BLOCK = 128
SB_HEADS = 8
SB_Q_BLOCK = 128
D_FF = 4 * D_MODEL

NSA_Q_W = NSA_HEADS * HEAD_DIM
NSA_KV_W = NSA_KV_HEADS * HEAD_DIM
NSA_GATE_W = NSA_HEADS * 3
DIL_W = DIL_HEADS * HEAD_DIM
SB_W = SB_HEADS * HEAD_DIM
PROJ_SIZES = (NSA_Q_W,) + (NSA_KV_W,) * 6 + (NSA_GATE_W,) + (DIL_W,) * 3 + (SB_W,) * 3
D_PROJ = sum(PROJ_SIZES)
SPLIT_POINTS = tuple(sum(PROJ_SIZES[:i + 1]) for i in range(len(PROJ_SIZES) - 1))

kernel_name = "hybrid_nsa_dilated_stickbreaking_block"


def rms_norm(x, g):
    x32 = x.astype(jnp.float32)
    y = x32 * lax.rsqrt(jnp.mean(x32 * x32, axis=-1, keepdims=True) + EPS)
    return (y * g.astype(jnp.float32)).astype(x.dtype)


def rope_tables(seq_len):
    inv = 1.0 / (ROPE_THETA ** (jnp.arange(0, HEAD_DIM, 2, dtype=jnp.float32) / HEAD_DIM))
    ang = jnp.arange(seq_len, dtype=jnp.float32)[:, None] * inv[None, :]
    return jnp.cos(ang), jnp.sin(ang)


def apply_rope(x, cos, sin):
    x32 = x.astype(jnp.float32)
    half = HEAD_DIM // 2
    x1, x2 = x32[..., :half], x32[..., half:]
    c, s = cos[None, :, None, :], sin[None, :, None, :]
    return jnp.concatenate([x1 * c - x2 * s, x1 * s + x2 * c], axis=-1).astype(x.dtype)


def nsa_compress(kv, pe, w1, w2):
    B, T, G, D = kv.shape
    nb = T // NSA_BLOCK
    blk = kv.reshape(B, nb, NSA_BLOCK, G, D) + pe[None, None, :, None, :].astype(kv.dtype)
    blk = blk.transpose(0, 1, 3, 2, 4).reshape(B, nb, G, NSA_BLOCK * D)
    return jax.nn.silu(blk @ w1) @ w2


def nsa_mixer(q, k_cmp, v_cmp, k_slc, v_slc, k_win, v_win, gate, pe_k, pe_v, w_ck1, w_ck2, w_cv1, w_cv2):
    B, T, H, D = q.shape
    G, R = NSA_KV_HEADS, NSA_GROUP
    scale = D ** -0.5
    nb = T // NSA_BLOCK
    pos = jnp.arange(T)
    qg = q.reshape(B, T, G, R, D)

    kc = nsa_compress(k_cmp, pe_k, w_ck1, w_ck2)
    vc = nsa_compress(v_cmp, pe_v, w_cv1, w_cv2)
    s_c = jnp.einsum('btgrd,bngd->bgrtn', qg, kc).astype(jnp.float32) * scale
    blk = jnp.arange(nb)
    cmp_ok = ((blk + 1) * NSA_BLOCK - 1)[None, :] <= pos[:, None]
    p_c = jax.nn.softmax(jnp.where(cmp_ok, s_c, NEG), axis=-1)
    p_c = p_c * jnp.any(cmp_ok, axis=-1)[:, None].astype(jnp.float32)
    o_cmp = jnp.einsum('bgrtn,bngd->btgrd', p_c.astype(vc.dtype), vc)

    imp = p_c.sum(axis=2)
    cur = pos // NSA_BLOCK
    started = blk[None, :] <= cur[:, None]
    forced = (blk[None, :] == 0) | (blk[None, :] == cur[:, None]) | (blk[None, :] == cur[:, None] - 1)
    imp = jnp.where(forced, NSA_FORCED_SCORE, jnp.where(started, imp, -1.0))
    n_sel = min(NSA_TOPN, nb)
    _, sel = lax.top_k(imp, n_sel)

    QB = NSA_Q_BLOCK
    nqb = T // QB
    ks_len = n_sel * NSA_BLOCK
    kT_s = k_slc.transpose(0, 2, 1, 3)
    vT_s = v_slc.transpose(0, 2, 1, 3)
    kw_pad = jnp.pad(k_win, ((0, 0), (NSA_WINDOW, 0), (0, 0), (0, 0)))
    vw_pad = jnp.pad(v_win, ((0, 0), (NSA_WINDOW, 0), (0, 0), (0, 0)))
    q_blocks = qg.reshape(B, nqb, QB, G, R, D).transpose(1, 0, 2, 3, 4, 5)
    sel_blocks = sel.reshape(B, G, nqb, QB, n_sel).transpose(2, 0, 1, 3, 4)
    gather = jax.vmap(jax.vmap(lambda a, idx: a[idx]))

    def body(args):
        i, qb, sb = args
        qpos = i * QB + jnp.arange(QB)
        tok = (sb[..., None] * NSA_BLOCK + jnp.arange(NSA_BLOCK)).reshape(B, G, QB * ks_len)
        ks = gather(kT_s, tok).reshape(B, G, QB, ks_len, D)
        vs = gather(vT_s, tok).reshape(B, G, QB, ks_len, D)
        s = jnp.einsum('bqgrd,bgqkd->bgrqk', qb, ks).astype(jnp.float32) * scale
        ok_s = tok.reshape(B, G, QB, ks_len) <= qpos[:, None]
        p = jax.nn.softmax(jnp.where(ok_s[:, :, None], s, NEG), axis=-1)
        o_s = jnp.einsum('bgrqk,bgqkd->bqgrd', p.astype(vs.dtype), vs)
        kw = lax.dynamic_slice_in_dim(kw_pad, i * QB, QB + NSA_WINDOW, axis=1)
        vw = lax.dynamic_slice_in_dim(vw_pad, i * QB, QB + NSA_WINDOW, axis=1)
        kpos = i * QB - NSA_WINDOW + jnp.arange(QB + NSA_WINDOW)
        ok_w = (kpos[None, :] >= 0) & (kpos[None, :] <= qpos[:, None]) & (kpos[None, :] > qpos[:, None] - NSA_WINDOW)
        s = jnp.einsum('bqgrd,bkgd->bgrqk', qb, kw).astype(jnp.float32) * scale
        p = jax.nn.softmax(jnp.where(ok_w, s, NEG), axis=-1)
        o_w = jnp.einsum('bgrqk,bkgd->bqgrd', p.astype(vw.dtype), vw)
        return o_s, o_w

    o_slc, o_win = lax.map(body, (jnp.arange(nqb), q_blocks, sel_blocks))
    o_slc = o_slc.transpose(1, 0, 2, 3, 4, 5).reshape(B, T, G, R, D)
    o_win = o_win.transpose(1, 0, 2, 3, 4, 5).reshape(B, T, G, R, D)

    g = jax.nn.sigmoid(gate.astype(jnp.float32)).reshape(B, T, G, R, 3, 1)
    o = (g[..., 0, :] * o_cmp.astype(jnp.float32) + g[..., 1, :] * o_slc.astype(jnp.float32)
         + g[..., 2, :] * o_win.astype(jnp.float32))
    return o.reshape(B, T, H * D).astype(q.dtype)


def dilated_group(q, k, v, window, dilation):
    B, T, h, D = q.shape
    L = window // dilation
    M = T // dilation
    QB = DIL_Q_BLOCK
    nb = -(-M // QB)
    Mp = nb * QB

    def to_sub(a, front):
        a = a.reshape(B, M, dilation, h, D).transpose(0, 2, 1, 3, 4)
        return jnp.pad(a, ((0, 0), (0, 0), (front, Mp - M), (0, 0), (0, 0)))

    qs = to_sub(q, 0).reshape(B, dilation, nb, QB, h, D)
    kidx = jnp.arange(nb)[:, None] * QB + jnp.arange(QB + L)[None, :]
    ks = to_sub(k, L)[:, :, kidx]
    vs = to_sub(v, L)[:, :, kidx]
    s = jnp.einsum('brnqhd,brnkhd->brnhqk', qs, ks).astype(jnp.float32) * (D ** -0.5)
    jj = jnp.arange(QB + L)[None, None, :]
    qq = jnp.arange(QB)[None, :, None]
    ii = jnp.arange(nb)[:, None, None]
    ok = (jj >= qq) & (jj <= qq + L) & (ii * QB + jj - L >= 0)
    s = jnp.where(ok[:, None], s, NEG)
    lse = jax.nn.logsumexp(s, axis=-1, keepdims=True)
    p = jnp.exp(s - lse)
    o = jnp.einsum('brnhqk,brnkhd->brnqhd', p.astype(vs.dtype), vs)
    o = o.reshape(B, dilation, Mp, h, D)[:, :, :M].transpose(0, 2, 1, 3, 4).reshape(B, T, h, D)
    lse = lse[..., 0].transpose(0, 1, 2, 4, 3).reshape(B, dilation, Mp, h)[:, :, :M]
    lse = lse.transpose(0, 2, 1, 3).reshape(B, T, h)
    return o, lse


def dilated_mixer(q, k, v):
    B, T, H, D = q.shape
    outs, lses = [], []
    for g, (w, d) in enumerate(DIL_PAIRS):
        sl = slice(g * DIL_HEADS_PER_PAIR, (g + 1) * DIL_HEADS_PER_PAIR)
        o, l = dilated_group(q[:, :, sl], k[:, :, sl], v[:, :, sl], w, d)
        outs.append(o)
        lses.append(l)
    alpha = jax.nn.softmax(jnp.stack(lses, axis=0), axis=0)
    o = jnp.concatenate([outs[g].astype(jnp.float32) * alpha[g][..., None] for g in range(len(DIL_PAIRS))], axis=2)
    return o.reshape(B, T, H * D).astype(q.dtype)


def stick_breaking_mixer(q, k, v):
    B, T, h, D = q.shape
    QB = SB_Q_BLOCK
    nqb = T // QB
    scale = D ** -0.5
    kpos = jnp.arange(T)
    q_blocks = q.reshape(B, nqb, QB, h, D).transpose(1, 0, 2, 3, 4)

    def body(args):
        i, qb = args
        qpos = i * QB + jnp.arange(QB)
        z = jnp.einsum('bqhd,bkhd->bhqk', qb, k).astype(jnp.float32) * scale
        before = kpos[None, :] < qpos[:, None]
        log_beta = jax.nn.log_sigmoid(z)
        log_1m = jnp.where(before, jax.nn.log_sigmoid(-z), 0.0)
        log_keep = lax.cumsum(log_1m, axis=3, reverse=True) - log_1m
        a = jnp.where(before, jnp.exp(log_beta + log_keep), 0.0)
        return jnp.einsum('bhqk,bkhd->bqhd', a.astype(v.dtype), v)

    o = lax.map(body, (jnp.arange(nqb), q_blocks))
    return o.transpose(1, 0, 2, 3, 4).reshape(B, T, h * D)


def hybrid_layer(x, cos, sin, w_in, g_mix, w_out, g_mlp, w_up, w_down, pe_k, pe_v, w_ck1, w_ck2, w_cv1, w_cv2):
    B, T, _ = x.shape
    h = rms_norm(x, g_mix)
    parts = jnp.split(h @ w_in, SPLIT_POINTS, axis=-1)
    (nq, nkc, nvc, nks, nvs, nkw, nvw, ngate, dq, dk, dv, sq, sk, sv) = parts
    heads = lambda a, n: a.reshape(B, T, n, HEAD_DIM)
    rope = lambda a: apply_rope(a, cos, sin)
    o_a = nsa_mixer(rope(heads(nq, NSA_HEADS)),
                    rope(heads(nkc, NSA_KV_HEADS)), heads(nvc, NSA_KV_HEADS),
                    rope(heads(nks, NSA_KV_HEADS)), heads(nvs, NSA_KV_HEADS),
                    rope(heads(nkw, NSA_KV_HEADS)), heads(nvw, NSA_KV_HEADS),
                    ngate, pe_k, pe_v, w_ck1, w_ck2, w_cv1, w_cv2)
    o_b = dilated_mixer(rope(heads(dq, DIL_HEADS)), rope(heads(dk, DIL_HEADS)), heads(dv, DIL_HEADS))
    o_c = stick_breaking_mixer(heads(sq, SB_HEADS), heads(sk, SB_HEADS), heads(sv, SB_HEADS))
    x = x + jnp.concatenate([o_a, o_b, o_c.astype(x.dtype)], axis=-1) @ w_out
    h2 = rms_norm(x, g_mlp)
    return x + jnp.square(jax.nn.relu(h2 @ w_up)) @ w_down


def setup_inputs(seed: int = 0) -> dict:
    key = jax.random.key(seed)
    ks = jax.random.split(key, 15)
    f32 = jnp.float32
    nrm = lambda k, shape, s: jax.random.normal(k, shape, f32) * s
    return {
        "x": nrm(ks[0], (BATCH, SEQ, D_MODEL), 1.0),
        "w_in": nrm(ks[1], (DEPTH, D_MODEL, D_PROJ), D_MODEL ** -0.5),
        "w_out": nrm(ks[2], (DEPTH, D_MODEL, D_MODEL), D_MODEL ** -0.5),
        "norm_mix": 1.0 + nrm(ks[3], (DEPTH, D_MODEL), 0.02),
        "norm_mlp": 1.0 + nrm(ks[4], (DEPTH, D_MODEL), 0.02),
        "w_up": nrm(ks[5], (DEPTH, D_MODEL, D_FF), D_MODEL ** -0.5),
        "w_down": nrm(ks[6], (DEPTH, D_FF, D_MODEL), D_FF ** -0.5),
        "nsa_pe_k": nrm(ks[7], (DEPTH, NSA_BLOCK, HEAD_DIM), 0.1),
        "nsa_pe_v": nrm(ks[8], (DEPTH, NSA_BLOCK, HEAD_DIM), 0.1),
        "nsa_w_ck1": nrm(ks[9], (DEPTH, NSA_BLOCK * HEAD_DIM, NSA_CMP_HIDDEN), (NSA_BLOCK * HEAD_DIM) ** -0.5),
        "nsa_w_ck2": nrm(ks[10], (DEPTH, NSA_CMP_HIDDEN, HEAD_DIM), NSA_CMP_HIDDEN ** -0.5),
        "nsa_w_cv1": nrm(ks[11], (DEPTH, NSA_BLOCK * HEAD_DIM, NSA_CMP_HIDDEN), (NSA_BLOCK * HEAD_DIM) ** -0.5),
        "nsa_w_cv2": nrm(ks[12], (DEPTH, NSA_CMP_HIDDEN, HEAD_DIM), NSA_CMP_HIDDEN ** -0.5),
        "final_norm": 1.0 + nrm(ks[13], (D_MODEL,), 0.02),
    }


def reference(x, w_in, w_out, norm_mix, norm_mlp, w_up, w_down, nsa_pe_k, nsa_pe_v,
              nsa_w_ck1, nsa_w_ck2, nsa_w_cv1, nsa_w_cv2, final_norm):
    cos, sin = rope_tables(x.shape[1])
    for layer in range(DEPTH):
        x = hybrid_layer(x, cos, sin, w_in[layer], norm_mix[layer], w_out[layer], norm_mlp[layer],
                         w_up[layer], w_down[layer], nsa_pe_k[layer], nsa_pe_v[layer],
                         nsa_w_ck1[layer], nsa_w_ck2[layer], nsa_w_cv1[layer], nsa_w_cv2[layer])
    return rms_norm(x, final_norm)
```

```cpp
#include <hip/hip_runtime.h>
#include <cstdio>
#include <cstdint>
namespace pg8 {
#define PG8_LAS __attribute__((address_space(3)))
typedef unsigned short bf16_t;
typedef short bf16x8 __attribute__((ext_vector_type(8)));
typedef float f32x4 __attribute__((ext_vector_type(4)));
typedef unsigned u32x4 __attribute__((ext_vector_type(4)));
constexpr int BM = 256, BK = 64, HALF = 128, HTB = HALF * BK * 2  , STAGE_BYTES = 8 * HTB, NXCD = 8, WGM = 8;

__host__ __device__ __forceinline__ int lds_byte(int r, int c) { const int st = (r >> 4) * 2 + (c >> 5), rr = r & 15, cc = c & 31, ob = rr * 64 + cc * 2; return st * 1024 + (ob ^ (((ob >> 9) & 1) << 5)); }
__host__ __device__ __forceinline__ void stage_rc(int b, int& R, int& C) { const int st = b / 1024, sb = b % 1024, swz = sb ^ (((sb >> 9) & 1) << 5); R = (st >> 1) * 16 + swz / 64; C = (st & 1) * 32 + (swz % 64) / 2; }
__host__ __device__ __forceinline__ int perm32(int rho) { const int n = rho >> 4, i = rho & 15; return 8 * (i >> 2) + 4 * n + (i & 3); }

struct Unit { int pm, pn; };
struct Gemm { const bf16_t* A; const bf16_t* Bt; int M, N, K; };

struct StaticOrder {
    int nM, nN, nwg, G, c;
    __host__ __device__ void init(int M, int N, int G_, int c_) { nM = M / BM; nN = N / BM; nwg = nM * nN; G = G_; c = c_; }
    __host__ __device__ bool next(int i, Unit& u) const {
        const long L = (long)i * G + c; if (L >= nwg) return false;
        int wgid = (int)L; { const int q = nwg / NXCD, r = nwg % NXCD, xcd = wgid % NXCD, off = wgid / NXCD; wgid = (xcd < r ? xcd * (q + 1) : r * (q + 1) + (xcd - r) * q) + off; }
        const int nig = WGM * nN, gid = wgid / nig, fm = gid * WGM, gsz = (nM - fm) < WGM ? (nM - fm) : WGM;
        u.pm = fm + ((wgid % nig) % gsz); u.pn = (wgid % nig) / gsz; return true;
    }
    __device__ __forceinline__ void a_ready(const Unit&) const {}
    __device__ __forceinline__ void done(const Unit&) const {}
};

__device__ __forceinline__ unsigned cvt_pk_bf16(float lo, float hi) { unsigned r; asm volatile("v_cvt_pk_bf16_f32 %0, %1, %2" : "=v"(r) : "v"(lo), "v"(hi)); return r; }
typedef unsigned u32x2 __attribute__((ext_vector_type(2)));
constexpr float SCL2 = 0.12751743082459868f;
struct EpiProj {
    static constexpr bool PERM = true, AFTER_DRAIN = false;
    bf16_t* O; int ldc; const float* cosT; const float* sinT; int seq;
    __device__ __forceinline__ void operator()(const f32x4 (&acc)[2][2][4][2], const Unit& u, int wr, int wc, int fr, int fq) const {
        const int row0 = u.pm * BM + wr * 64 + fr, pn = u.pn;
        const bool scaled = (pn < 6) || (pn >= 9 && pn < 15) || (pn >= 30 && pn < 34);
        const float sc = scaled ? SCL2 : 1.0f;
        if (pn < 21) {
            const int j = 4 * wc + fq;
#pragma unroll
            for (int ai = 0; ai < 2; ++ai)
#pragma unroll
                for (int m = 0; m < 4; ++m) { const int row = row0 + ai * HALF + m * 16, t = row & (seq - 1);
                    const f32x4 c4 = *(const f32x4*)(cosT + t * 64 + 4 * j), s4 = *(const f32x4*)(sinT + t * 64 + 4 * j);
                    bf16_t* rowp = O + (size_t)row * ldc + pn * BM;
#pragma unroll
                    for (int bj = 0; bj < 2; ++bj) { const f32x4 x1 = acc[ai][bj][m][0] * sc, x2 = acc[ai][bj][m][1] * sc;
                        const f32x4 o1 = x1 * c4 - x2 * s4, o2 = x1 * s4 + x2 * c4;
                        u32x2 w1, w2; w1.x = cvt_pk_bf16(o1[0], o1[1]); w1.y = cvt_pk_bf16(o1[2], o1[3]); w2.x = cvt_pk_bf16(o2[0], o2[1]); w2.y = cvt_pk_bf16(o2[2], o2[3]);
                        *(u32x2*)(rowp + bj * HALF + 4 * j) = w1; *(u32x2*)(rowp + bj * HALF + 64 + 4 * j) = w2; } }
        } else {
            const int col0 = pn * BM + wc * 32 + 8 * fq;
#pragma unroll
            for (int ai = 0; ai < 2; ++ai)
#pragma unroll
                for (int m = 0; m < 4; ++m) { bf16_t* rowp = O + (size_t)(row0 + ai * HALF + m * 16) * ldc + col0;
#pragma unroll
                    for (int bj = 0; bj < 2; ++bj) { const f32x4 v0 = acc[ai][bj][m][0] * sc, v1 = acc[ai][bj][m][1] * sc;
                        u32x4 w; w.x = cvt_pk_bf16(v0[0], v0[1]); w.y = cvt_pk_bf16(v0[2], v0[3]); w.z = cvt_pk_bf16(v1[0], v1[1]); w.w = cvt_pk_bf16(v1[2], v1[3]);
                        *(u32x4*)(rowp + bj * HALF) = w; } }
        }
    }
};
struct EpiResid {
    static constexpr bool PERM = false, AFTER_DRAIN = false;
    const float* base; float* out; int ldc;
    __device__ __forceinline__ void operator()(const f32x4 (&acc)[2][2][4][2], const Unit& u, int wr, int wc, int fr, int fq) const {
        const int row0 = u.pm * BM + wr * 64 + fr, col0 = u.pn * BM + wc * 32 + 4 * fq;
#pragma unroll
        for (int ai = 0; ai < 2; ++ai)
#pragma unroll
            for (int m = 0; m < 4; ++m) { const size_t off = (size_t)(row0 + ai * HALF + m * 16) * ldc + col0;
                f32x4 b[2][2];
#pragma unroll
                for (int bj = 0; bj < 2; ++bj)
#pragma unroll
                    for (int n = 0; n < 2; ++n) b[bj][n] = *(const f32x4*)(base + off + bj * HALF + n * 16);
#pragma unroll
                for (int bj = 0; bj < 2; ++bj)
#pragma unroll
                    for (int n = 0; n < 2; ++n) *(f32x4*)(out + off + bj * HALF + n * 16) = b[bj][n] + acc[ai][bj][m][n];
                asm volatile("" ::: "memory"); }
    }
};
struct EpiRelu2 {
    static constexpr bool PERM = true, AFTER_DRAIN = false;
    bf16_t* O; int ldc;
    __device__ __forceinline__ void operator()(const f32x4 (&acc)[2][2][4][2], const Unit& u, int wr, int wc, int fr, int fq) const {
        const int row0 = u.pm * BM + wr * 64 + fr, col0 = u.pn * BM + wc * 32 + 8 * fq;
#pragma unroll
        for (int ai = 0; ai < 2; ++ai)
#pragma unroll
            for (int m = 0; m < 4; ++m) { bf16_t* rowp = O + (size_t)(row0 + ai * HALF + m * 16) * ldc + col0;
#pragma unroll
                for (int bj = 0; bj < 2; ++bj) { f32x4 v0 = acc[ai][bj][m][0], v1 = acc[ai][bj][m][1];
#pragma unroll
                    for (int e = 0; e < 4; ++e) { const float a = fmaxf(v0[e], 0.f), b = fmaxf(v1[e], 0.f); v0[e] = a * a; v1[e] = b * b; }
                    u32x4 w; w.x = cvt_pk_bf16(v0[0], v0[1]); w.y = cvt_pk_bf16(v0[2], v0[3]); w.z = cvt_pk_bf16(v1[0], v1[1]); w.w = cvt_pk_bf16(v1[2], v1[3]);
                    *(u32x4*)(rowp + bj * HALF) = w; } }
    }
};

template <class Epi, class Sched, bool ALIGN_EPI = false, bool SP2 = false>
__device__ __forceinline__ void gemm_phase(PG8_LAS unsigned char* lds, const Gemm g, const Sched& S, const Epi& E, const int wid_in) {
    int lane = (int)__builtin_amdgcn_mbcnt_hi(~0u, __builtin_amdgcn_mbcnt_lo(~0u, 0u)); asm volatile("" : "+v"(lane));
    const int wid = wid_in, tid = wid * 64 + lane, wr = wid >> 2, wc = wid & 3, fr = lane & 15, fq = lane >> 4;
    const int K = g.K, nt = K / BK;
    unsigned voffA[2], voffB[2];
#pragma unroll
    for (int i = 0; i < 2; ++i) { int R, C; stage_rc(tid * 16 + i * 8192, R, C); const int Rb = Epi::PERM ? ((R & ~31) + perm32(R & 31)) : R;
        voffA[i] = (unsigned)(R * K + C) * 2u; voffB[i] = (unsigned)(Rb * K + C) * 2u; }
    const size_t kstep = (size_t)(BK * 2);
    const size_t hstep = (size_t)HALF * K * 2;
    const size_t tstep = 2 * hstep;
    const unsigned ldsw = (unsigned)wid * 1024u;
    const int aoff = lds_byte(wr * 64 + fr, fq * 8), boff = lds_byte(wc * 32 + fr, fq * 8);
#define PG8_SA(b, h) (((b) * 2 + (h)) * HTB)
#define PG8_SB(b, h) ((4 + (b) * 2 + (h)) * HTB)
#define PG8_STAGE(bufoff, gbase, voff) do { _Pragma("unroll") for (int _i = 0; _i < 2; ++_i) \
        __builtin_amdgcn_global_load_lds((const unsigned*)((const char*)(gbase) + (voff)[_i]), (PG8_LAS unsigned*)(lds + (bufoff) + ldsw + _i * 8192), 16, 0, 0); } while (0)
#define PG8_LDA(dst, b, h) do { _Pragma("unroll") for (int m = 0; m < 4; ++m) _Pragma("unroll") for (int k = 0; k < 2; ++k) dst[m][k] = *(const PG8_LAS bf16x8*)(lds + PG8_SA(b, h) + aoff + m * 2048 + k * 1024); } while (0)
#define PG8_LDB(dst, b, h) do { _Pragma("unroll") for (int n = 0; n < 2; ++n) _Pragma("unroll") for (int k = 0; k < 2; ++k) dst[n][k] = *(const PG8_LAS bf16x8*)(lds + PG8_SB(b, h) + boff + n * 2048 + k * 1024); } while (0)
#define PG8_MMA(ai, bj, At, Bt) do { __builtin_amdgcn_s_setprio(1); _Pragma("unroll") for (int m = 0; m < 4; ++m) _Pragma("unroll") for (int n = 0; n < 2; ++n) _Pragma("unroll") for (int k = 0; k < 2; ++k) \
        acc[ai][bj][m][n] = __builtin_amdgcn_mfma_f32_16x16x32_bf16(Bt[n][k], At[m][k], acc[ai][bj][m][n], 0, 0, 0); __builtin_amdgcn_s_setprio(0); } while (0)
#define PG8_WAIT_V(n) asm volatile("s_waitcnt vmcnt(" #n ")" ::: "memory")
#define PG8_WAIT_L(n) asm volatile("s_waitcnt lgkmcnt(" #n ")" ::: "memory")
#define PG8_BAR __builtin_amdgcn_s_barrier()
#define PG8_SCHED __builtin_amdgcn_sched_barrier(0)
    Unit cur, nxt; int ui = 0;
    if (!S.next(0, cur)) return;
    f32x4 acc[2][2][4][2];
#pragma unroll
    for (int a = 0; a < 2; ++a)
#pragma unroll
        for (int b = 0; b < 2; ++b)
#pragma unroll
            for (int m = 0; m < 4; ++m)
#pragma unroll
                for (int n = 0; n < 2; ++n) acc[a][b][m][n] = (f32x4){0.f, 0.f, 0.f, 0.f};
    bf16x8 At[4][2], B0[2][2], B1[2][2];
    const char* cA = (const char*)g.A + (size_t)cur.pm * tstep; const char* cB = (const char*)g.Bt + (size_t)cur.pn * tstep;
    S.a_ready(cur);
    if constexpr (SP2) {
        PG8_STAGE(PG8_SB(0, 0), cB, voffB); PG8_STAGE(PG8_SB(0, 1), cB + hstep, voffB); PG8_STAGE(PG8_SA(0, 0), cA, voffA); PG8_STAGE(PG8_SA(0, 1), cA + hstep, voffA);
        if (wr == 1) PG8_BAR;
        PG8_WAIT_V(2); PG8_BAR;
        PG8_STAGE(PG8_SB(1, 0), cB + kstep, voffB); PG8_STAGE(PG8_SA(1, 0), cA + kstep, voffA); PG8_STAGE(PG8_SB(1, 1), cB + hstep + kstep, voffB);
        PG8_WAIT_V(6); PG8_BAR;
    } else {
        PG8_STAGE(PG8_SB(0, 0), cB, voffB); PG8_STAGE(PG8_SA(0, 0), cA, voffA); PG8_STAGE(PG8_SB(0, 1), cB + hstep, voffB); PG8_STAGE(PG8_SA(0, 1), cA + hstep, voffA);
        if (wr == 1) PG8_BAR;
        PG8_WAIT_V(4); PG8_BAR;
        PG8_STAGE(PG8_SB(1, 0), cB + kstep, voffB); PG8_STAGE(PG8_SA(1, 0), cA + kstep, voffA); PG8_STAGE(PG8_SB(1, 1), cB + hstep + kstep, voffB);
        PG8_WAIT_V(6); PG8_BAR;
    }
    for (;;) {
        const bool has_next = S.next(ui + 1, nxt);
        const char* nA = has_next ? (const char*)g.A + (size_t)nxt.pm * tstep : cA; const char* nB = has_next ? (const char*)g.Bt + (size_t)nxt.pn * tstep : cB;
        for (int t = 0; t < nt; t += 2) {
            const bool last = (t == nt - 2);
            const char* a1 = cA + (size_t)(t + 1) * kstep;
            const char* a2 = last ? nA : cA + (size_t)(t + 2) * kstep; const char* b2 = last ? nB : cB + (size_t)(t + 2) * kstep;
            const char* a3 = a2 + kstep; const char* b3 = b2 + kstep;
            if (last && has_next) S.a_ready(nxt);
            if constexpr (SP2) {
            PG8_LDB(B0, 0, 0); PG8_LDB(B1, 0, 1); PG8_SCHED; PG8_LDA(At, 0, 0); PG8_STAGE(PG8_SA(1, 1), a1 + hstep, voffA);
            PG8_WAIT_V(8); PG8_WAIT_L(0); PG8_BAR; PG8_MMA(0, 0, At, B0); PG8_MMA(0, 1, At, B1); PG8_BAR; PG8_SCHED;
            PG8_LDA(At, 0, 1); PG8_STAGE(PG8_SB(0, 0), b2, voffB); PG8_STAGE(PG8_SB(0, 1), b2 + hstep, voffB); PG8_STAGE(PG8_SA(0, 0), a2, voffA);
            PG8_WAIT_V(8); PG8_WAIT_L(0); PG8_BAR; PG8_MMA(1, 0, At, B0); PG8_MMA(1, 1, At, B1); PG8_BAR; PG8_SCHED;
            PG8_LDB(B0, 1, 0); PG8_LDB(B1, 1, 1); PG8_SCHED; PG8_LDA(At, 1, 0); PG8_STAGE(PG8_SA(0, 1), a2 + hstep, voffA);
            PG8_WAIT_V(8); PG8_WAIT_L(0); PG8_BAR; PG8_MMA(0, 0, At, B0); PG8_MMA(0, 1, At, B1); PG8_BAR; PG8_SCHED;
            PG8_LDA(At, 1, 1); PG8_STAGE(PG8_SB(1, 0), b3, voffB); PG8_STAGE(PG8_SB(1, 1), b3 + hstep, voffB); PG8_STAGE(PG8_SA(1, 0), a3, voffA);
            PG8_WAIT_V(8); PG8_WAIT_L(0); PG8_BAR; PG8_MMA(1, 0, At, B0); PG8_MMA(1, 1, At, B1); PG8_BAR; PG8_SCHED;
            } else {
            PG8_LDB(B0, 0, 0); PG8_SCHED; PG8_LDA(At, 0, 0); PG8_STAGE(PG8_SA(1, 1), a1 + hstep, voffA);
            PG8_WAIT_L(8); PG8_BAR; PG8_WAIT_L(0); PG8_MMA(0, 0, At, B0); PG8_BAR; PG8_SCHED;
            PG8_LDB(B1, 0, 1); PG8_STAGE(PG8_SB(0, 0), b2, voffB);
            PG8_BAR; PG8_WAIT_L(0); PG8_MMA(0, 1, At, B1); PG8_BAR;
            PG8_LDA(At, 0, 1); PG8_STAGE(PG8_SA(0, 0), a2, voffA);
            PG8_BAR; PG8_WAIT_L(0); PG8_MMA(1, 0, At, B0); PG8_BAR; PG8_SCHED;
            PG8_STAGE(PG8_SB(0, 1), b2 + hstep, voffB);
            PG8_WAIT_V(6); PG8_BAR; PG8_MMA(1, 1, At, B1); PG8_BAR;
            PG8_LDB(B0, 1, 0); PG8_SCHED; PG8_LDA(At, 1, 0); PG8_STAGE(PG8_SA(0, 1), a2 + hstep, voffA);
            PG8_WAIT_L(8); PG8_BAR; PG8_WAIT_L(0); PG8_MMA(0, 0, At, B0); PG8_BAR; PG8_SCHED;
            PG8_LDB(B1, 1, 1); PG8_STAGE(PG8_SB(1, 0), b3, voffB);
            PG8_BAR; PG8_WAIT_L(0); PG8_MMA(0, 1, At, B1); PG8_BAR;
            PG8_LDA(At, 1, 1); PG8_STAGE(PG8_SA(1, 0), a3, voffA);
            PG8_BAR; PG8_WAIT_L(0); PG8_MMA(1, 0, At, B0); PG8_BAR; PG8_SCHED;
            PG8_STAGE(PG8_SB(1, 1), b3 + hstep, voffB);
            PG8_WAIT_V(6); PG8_BAR; PG8_MMA(1, 1, At, B1); PG8_BAR;
            }
        }
        if constexpr (ALIGN_EPI) { if (wr == 0) PG8_BAR; }
        if constexpr (!Epi::AFTER_DRAIN) { E(acc, cur, wr, wc, fr, fq); S.done(cur); }
        if (!has_next) break;
#pragma unroll
        for (int a = 0; a < 2; ++a)
#pragma unroll
            for (int b = 0; b < 2; ++b)
#pragma unroll
                for (int m = 0; m < 4; ++m)
#pragma unroll
                    for (int n = 0; n < 2; ++n) acc[a][b][m][n] = (f32x4){0.f, 0.f, 0.f, 0.f};
        cur = nxt; cA = nA; cB = nB; ++ui;
        if constexpr (ALIGN_EPI) { if (wr == 1) PG8_BAR; }
    }
    PG8_WAIT_V(0);
    if constexpr (!ALIGN_EPI) { if (wr == 0) PG8_BAR; }
    PG8_BAR;
    if constexpr (Epi::AFTER_DRAIN) { E.fused(acc, cur, wr, wc, fr, fq, lds, wid, lane); S.done(cur); }
#undef PG8_SA
#undef PG8_SB
#undef PG8_STAGE
#undef PG8_LDA
#undef PG8_LDB
#undef PG8_MMA
#undef PG8_WAIT_V
#undef PG8_WAIT_L
#undef PG8_BAR
#undef PG8_SCHED
}
}
#define GAS __attribute__((address_space(1)))
#define LAS __attribute__((address_space(3)))
typedef unsigned short bf16;
typedef unsigned v4u __attribute__((ext_vector_type(4)));
typedef float f32x4 __attribute__((ext_vector_type(4)));
typedef short bf16x8 __attribute__((ext_vector_type(8)));
typedef GAS unsigned gu32;
typedef GAS unsigned long long gu64;
#define RLX_AGENT __ATOMIC_RELAXED, __HIP_MEMORY_SCOPE_AGENT
#define LDS_WAIT() asm volatile("s_waitcnt lgkmcnt(0)" ::: "memory")
#define VM_WAIT() asm volatile("s_waitcnt vmcnt(0)" ::: "memory")
__device__ __forceinline__ unsigned long long rt() { return __builtin_amdgcn_s_memrealtime(); }
__device__ __forceinline__ unsigned f2bf(float f) { unsigned u = __builtin_bit_cast(unsigned, f); return (u + 0x7fffu + ((u >> 16) & 1u)) >> 16; }
__device__ __forceinline__ unsigned pk2(float lo, float hi) { return f2bf(lo) | (f2bf(hi) << 16); }

#define XB_TMO      128
#define XB_XCNT(j)  (256  + 64 * (j))
#define XB_XSUB(j)  (1280 + 64 * (j))
#define XB_XGEN(j)  (2304 + 64 * (j))
#define XB_TOP      3328
#define XB_TOPGEN   3392
#define XCD_BAR_WORDS 3456
#define XB_SPIN_CAP (1u << 18)

__device__ __forceinline__ unsigned xb_ld(unsigned* p)              { return __hip_atomic_load(p, __ATOMIC_RELAXED, __HIP_MEMORY_SCOPE_AGENT); }
__device__ __forceinline__ unsigned xb_add(unsigned* p, unsigned v) { return __hip_atomic_fetch_add(p, v, __ATOMIC_RELAXED, __HIP_MEMORY_SCOPE_AGENT); }
__device__ __forceinline__ unsigned xb_xcc_id() { return (unsigned)__builtin_amdgcn_s_getreg((3 << 11) | 20) & 0xFu; }
#define XB_SPIN(cond, bar) do { unsigned _sp = 0; while (cond) { __builtin_amdgcn_s_sleep(1); \
    if ((++_sp & 255u) == 0u) { if (xb_ld(&(bar)[XB_TMO])) break; if (_sp > XB_SPIN_CAP) { atomicAdd(&(bar)[XB_TMO], 1u); break; } } } } while (0)

struct XcdBarrier {
    unsigned* bar; unsigned x;
    volatile LAS unsigned* st;
};

__device__ __forceinline__ XcdBarrier xcd_barrier_post(unsigned* bar, volatile LAS unsigned* st) {
    XcdBarrier b; b.bar = bar; b.x = xb_xcc_id(); b.st = st;
    if (threadIdx.x == 0) (void)xb_add(&bar[XB_XCNT(b.x)], 1u);
    return b;
}
__device__ __forceinline__ void xcd_barrier_complete(unsigned* bar, unsigned x, unsigned& nloc, unsigned& nx) {
    const unsigned G = gridDim.x * gridDim.y * gridDim.z;
    unsigned sum, cnt, mine, sp = 0u;
    for (;;) {
        sum = 0u; cnt = 0u; mine = 0u;
#pragma unroll
        for (unsigned j = 0; j < 16; ++j) { const unsigned c = xb_ld(&bar[XB_XCNT(j)]); sum += c; cnt += (c > 0u) ? 1u : 0u; mine = (j == x) ? c : mine; }
        if (sum == G) break;
        __builtin_amdgcn_s_sleep(1);
        if ((++sp & 255u) == 0u) { if (xb_ld(&bar[XB_TMO])) break; if (sp > XB_SPIN_CAP) { atomicAdd(&bar[XB_TMO], 1u); break; } }
    }
    nloc = mine > 0u ? mine : 1u; nx = cnt > 0u ? cnt : 1u;
}

__device__ __forceinline__ void xcd_barrier(const XcdBarrier& b) {
    asm volatile("s_waitcnt vmcnt(0)" ::: "memory");
    __syncthreads();
    if (threadIdx.x == 0) {
        unsigned* bar = b.bar;
        __builtin_amdgcn_s_waitcnt(0);
        unsigned nloc = b.st[0], nx = b.st[1];
        if (nloc == 0u) { xcd_barrier_complete(bar, b.x, nloc, nx); b.st[0] = nloc; b.st[1] = nx; }
        const unsigned old = xb_add(&bar[XB_XSUB(b.x)], 1u);
        const unsigned gen = old / nloc;
        if (old + 1u == (gen + 1u) * nloc) {
            __builtin_amdgcn_fence(__ATOMIC_RELEASE, "agent");
            asm volatile("s_waitcnt vmcnt(0)" ::: "memory");
            const unsigned og = xb_add(&bar[XB_TOP], 1u);
            const unsigned tg = og / nx;
            if (og + 1u == (tg + 1u) * nx) xb_add(&bar[XB_TOPGEN], 1u);
            else XB_SPIN(xb_ld(&bar[XB_TOPGEN]) == tg, bar);
            __builtin_amdgcn_fence(__ATOMIC_ACQUIRE, "agent");
            xb_add(&bar[XB_XGEN(b.x)], 1u);
            asm volatile("s_waitcnt vmcnt(0)" ::: "memory");
        } else {
            XB_SPIN(xb_ld(&bar[XB_XGEN(b.x)]) == gen, bar);
            __builtin_amdgcn_fence(__ATOMIC_ACQUIRE, "agent");
            asm volatile("s_waitcnt vmcnt(0)" ::: "memory");
        }
    }
    __syncthreads();
}

constexpr int NWAVES = 8;
#ifndef MK_ONE_LAUNCH
#define MK_ONE_LAUNCH 0
#endif
constexpr int BATCH = 2, SEQ = 4096, MTOK = BATCH * SEQ, DM = 4096, HD = 128, DFF = 16384, DEPTH = 2;
constexpr int NSRC = 10788, NP = 11008;
constexpr float RMS_EPS = 1e-6f;
constexpr int C_NQ = 0, C_KC = 1536, C_KS = 1792, C_KW = 2048, C_DQ = 2304, C_DK = 3840, C_VC = 5376, C_VS = 5632, C_VW = 5888, C_DV = 6144, C_SQ = 7680, C_SK = 8704, C_SV = 9728, C_GT = 10752;
constexpr size_t MiB = 1u << 20;
constexpr size_t WS_CTL = 0, CTL_ZERO_BYTES = 1 * MiB;
constexpr size_t WS_COS = 1 * MiB, WS_SIN = 2 * MiB, WS_KC = 3 * MiB, WS_SEL = 4 * MiB;
constexpr size_t WS_WIN = 8 * MiB, WIN_L = (size_t)NP * DM * 2;
constexpr size_t WS_WOUT = 180 * MiB, WOUT_L = (size_t)DM * DM * 2;
constexpr size_t WS_WUP = 244 * MiB, WUP_L = (size_t)DFF * DM * 2;
constexpr size_t WS_WDN = 500 * MiB, WDN_L = (size_t)DM * DFF * 2;
constexpr size_t WS_H = 756 * MiB, WS_PROJ = 820 * MiB, WS_OCAT = 992 * MiB, WS_X = 1056 * MiB, WS_U = 1184 * MiB, WS_OCMP = 1440 * MiB, WS_END = 1488 * MiB;
static_assert(WS_WIN + 2 * WIN_L <= WS_WOUT && WS_PROJ + (size_t)MTOK * NP * 2 <= WS_OCAT, "ws map");
constexpr int CW_TMO = 0, CW_CODE = 1, CW_BAR = 4096;
constexpr int NPH = 1 + 9 * DEPTH;
static_assert((CW_BAR + NPH * 3456) * 4 <= (int)CTL_ZERO_BYTES, "ctl");
constexpr int MISC_OFF = 0, RING_OFF = 1024, RING_BYTES = 131072, LDS_BYTES = 147456;

struct Frame {
    LAS unsigned char* lds; volatile LAS unsigned* MISC;
    int wave;
};
struct Ctx { LAS unsigned char* lds; int wave, lane, tid, G, bid, gw, ngw; };
#define CTX() Ctx C; do { int w_ = F.wave, g_ = (int)gridDim.x, b_ = (int)blockIdx.x; asm volatile("" : "+s"(w_), "+s"(g_), "+s"(b_)); C.lds = F.lds; C.wave = w_; C.G = g_; C.bid = b_; \
    C.gw = b_ * NWAVES + w_; C.ngw = g_ * NWAVES; C.lane = fresh_lane(); C.tid = w_ * 64 + C.lane; } while (0)
__device__ __forceinline__ int fresh_lane() { int l = (int)__builtin_amdgcn_mbcnt_hi(~0u, __builtin_amdgcn_mbcnt_lo(~0u, 0u)); asm volatile("" : "+v"(l)); return l; }
constexpr int PT_OUT = 14, PT_WS = 15;
__device__ __forceinline__ unsigned long long rd_ptr(const Frame& F, int k) {
    const unsigned lo = F.MISC[16 + 2 * k], hi = F.MISC[17 + 2 * k];
    return ((unsigned long long)(unsigned)__builtin_amdgcn_readfirstlane((int)hi) << 32) | (unsigned)__builtin_amdgcn_readfirstlane((int)lo);
}
#define PIN(k) ((const float*)rd_ptr(F, (k)))
#define PWS(T, off) ((T*)(rd_ptr(F, PT_WS) + (off)))
__device__ __forceinline__ float wave_sum(float v) {
#pragma unroll
    for (int o = 1; o < 64; o <<= 1) v += __shfl_xor(v, o);
    return v;
}
__device__ __forceinline__ float wave_max(float v) {
#pragma unroll
    for (int o = 1; o < 64; o <<= 1) v = fmaxf(v, __shfl_xor(v, o));
    return v;
}
__device__ __forceinline__ float bf2f(bf16 v) { return __uint_as_float((unsigned)v << 16); }
__device__ __forceinline__ float blo(unsigned w) { return __uint_as_float(w << 16); }
__device__ __forceinline__ float bhi(unsigned w) { return __uint_as_float(w & 0xffff0000u); }
__device__ __forceinline__ float ex2(float x) { return __builtin_amdgcn_exp2f(x); }
__device__ __forceinline__ float lg2(float x) { return __builtin_amdgcn_logf(x); }

__device__ __forceinline__ int il128(int d) { return ((d & 63) >> 2) * 8 + (d >> 6) * 4 + (d & 3); }
__device__ __forceinline__ int win_dest(int c) {
    if (c < 1536) return C_NQ + (c & ~127) + il128(c & 127);
    if (c < 3072) { const int e = c - 1536, seg = e >> 8, w = e & 255;
        const int base = seg == 0 ? C_KC : seg == 1 ? C_VC : seg == 2 ? C_KS : seg == 3 ? C_VS : seg == 4 ? C_KW : C_VW;
        return base + (w & ~127) + ((seg & 1) ? (w & 127) : il128(w & 127)); }
    if (c < 3108) return C_GT + (c - 3072);
    if (c < 4644) { const int e = c - 3108; return C_DQ + (e & ~127) + il128(e & 127); }
    if (c < 6180) { const int e = c - 4644; return C_DK + (e & ~127) + il128(e & 127); }
    if (c < 7716) return C_DV + (c - 6180);
    if (c < 8740) return C_SQ + (c - 7716);
    if (c < 9764) return C_SK + (c - 8740);
    return C_SV + (c - 9764);
}
template <bool MAPPED>
__device__ __forceinline__ void transpose_item(const float* W, int K, int N, bf16* WT, LAS float* scr, int kb, int nb, int lane) {
    const int k0 = 64 * kb, n0 = 64 * nb, n = n0 + lane; const bool ok = n < N;
    const float* src = W + (size_t)k0 * N + (ok ? n : 0);
#pragma unroll 16
    for (int kk = 0; kk < 64; ++kk) { const float v = src[(size_t)kk * N]; scr[kk * 65 + lane] = ok ? v : 0.f; }
    LDS_WAIT(); asm volatile("" ::: "memory");
    const int c = lane & 7;
#pragma unroll
    for (int j = 0; j < 8; ++j) { const int nn = (lane >> 3) + 8 * j, ns = n0 + nn;
        if (ns < N) { const int dr = MAPPED ? win_dest(ns) : ns; const LAS float* s = scr + (8 * c) * 65 + nn;
            v4u o; o.x = pk2(s[0 * 65], s[1 * 65]); o.y = pk2(s[2 * 65], s[3 * 65]); o.z = pk2(s[4 * 65], s[5 * 65]); o.w = pk2(s[6 * 65], s[7 * 65]);
            *(v4u*)(WT + (size_t)dr * K + k0 + 8 * c) = o; } }
    LDS_WAIT(); asm volatile("" ::: "memory");
}
__device__ __forceinline__ void sincos_red(double x, double& s, double& c) {
    const double kd = rint(x * 0.63661977236758134308);
    double r = fma(-kd, 1.57079632679489655800e+00, x); r = fma(-kd, 6.12323399573676603587e-17, r);
    const int q = ((int)kd) & 3; const double r2 = r * r;
    const double sp = r * (1.0 + r2 * (-1.0 / 6 + r2 * (1.0 / 120 + r2 * (-1.0 / 5040 + r2 * (1.0 / 362880 + r2 * (-1.0 / 39916800 + r2 * (1.0 / 6227020800.0)))))));
    const double cp = 1.0 + r2 * (-0.5 + r2 * (1.0 / 24 + r2 * (-1.0 / 720 + r2 * (1.0 / 40320 + r2 * (-1.0 / 3628800 + r2 * (1.0 / 479001600.0 + r2 * (-1.0 / 87178291200.0)))))));
    s = (q == 0) ? sp : (q == 1) ? cp : (q == 2) ? -sp : -cp;
    c = (q == 0) ? cp : (q == 1) ? -sp : (q == 2) ? -cp : sp;
}
__device__ __forceinline__ void rms_row(const float* xrow, const float* g, bf16* ob, float* of, int lane) {
    const f32x4* xr = (const f32x4*)xrow + lane; f32x4 v[16]; float s = 0.f;
#pragma unroll
    for (int j = 0; j < 16; ++j) { v[j] = xr[64 * j]; s += (v[j].x * v[j].x + v[j].y * v[j].y) + (v[j].z * v[j].z + v[j].w * v[j].w); }
    const float rstd = 1.0f / sqrtf(wave_sum(s) * (1.0f / DM) + RMS_EPS);
    const f32x4* gr = (const f32x4*)g + lane;
#pragma unroll
    for (int j = 0; j < 16; ++j) { const f32x4 gv = gr[64 * j]; const f32x4 y = v[j] * rstd * gv;
        if (ob) ((unsigned long long*)ob)[lane + 64 * j] = (unsigned long long)pk2(y.x, y.y) | ((unsigned long long)pk2(y.z, y.w) << 32);
        else ((f32x4*)of)[lane + 64 * j] = y; }
}
__device__ __forceinline__ void norm_phase(const Ctx& C, const float* xin, const float* g, bf16* ob, float* of) {
    const int lane = C.lane;
    for (int m = C.gw; m < MTOK; m += C.ngw) rms_row(xin + (size_t)m * DM, g, ob ? ob + (size_t)m * DM : nullptr, of ? of + (size_t)m * DM : nullptr, lane);
}
__device__ __forceinline__ void p0_prologue(const Frame& F, const Ctx& C) {
    const int lane = C.lane, tid = C.tid;
    LAS float* scr = (LAS float*)(C.lds + RING_OFF + C.wave * 16640);
    constexpr int NB_IN = (NSRC + 63) / 64, I_IN = 64 * NB_IN, I_OUT = 64 * 64, I_UP = 64 * 256, I_DN = 256 * 64, I_L = I_IN + I_OUT + I_UP + I_DN;
    {
        const float* w_in = PIN(1); const float* w_out = PIN(2); const float* w_up = PIN(5); const float* w_dn = PIN(6);
        bf16* Win_t = PWS(bf16, WS_WIN); bf16* Wout_t = PWS(bf16, WS_WOUT); bf16* Wup_t = PWS(bf16, WS_WUP); bf16* Wdn_t = PWS(bf16, WS_WDN);
        for (int it = C.gw; it < DEPTH * I_L; it += C.ngw) {
            const int L = it / I_L; int r = it - L * I_L;
            if (r < I_IN) { transpose_item<true>(w_in + (size_t)L * DM * NSRC, DM, NSRC, Win_t + (size_t)L * NP * DM, scr, r / NB_IN, r % NB_IN, lane); continue; } r -= I_IN;
            if (r < I_OUT) { transpose_item<false>(w_out + (size_t)L * DM * DM, DM, DM, Wout_t + (size_t)L * DM * DM, scr, r / 64, r % 64, lane); continue; } r -= I_OUT;
            if (r < I_UP) { transpose_item<false>(w_up + (size_t)L * DM * DFF, DM, DFF, Wup_t + (size_t)L * DFF * DM, scr, r / 256, r % 256, lane); continue; } r -= I_UP;
            transpose_item<false>(w_dn + (size_t)L * DFF * DM, DFF, DM, Wdn_t + (size_t)L * DM * DFF, scr, r / 64, r % 64, lane);
        }
        for (int it = C.gw; it < DEPTH * (NP - NSRC); it += C.ngw) { const int L = it / (NP - NSRC), r = NSRC + it % (NP - NSRC);
            v4u* p = (v4u*)(Win_t + (size_t)L * NP * DM + (size_t)r * DM); const v4u z = {0u, 0u, 0u, 0u};
#pragma unroll
            for (int j = 0; j < 8; ++j) p[lane + 64 * j] = z; }
    }
    {
        float* cosT = PWS(float, WS_COS); float* sinT = PWS(float, WS_SIN);
        for (int e = C.bid * (NWAVES * 64) + tid; e < SEQ * 64; e += C.G * NWAVES * 64) { const int t = e >> 6, i = e & 63;
            double p = 1.0; for (int k = 0; k < i; ++k) p *= 1.1547819846894583;
            const float pf = (float)p, inv = (float)(1.0 / (double)pf), ang = __fmul_rn((float)t, inv);
            double s, c; sincos_red((double)ang, s, c); cosT[e] = (float)c; sinT[e] = (float)s; }
    }
    norm_phase(C, PIN(0), PIN(3), PWS(bf16, WS_H), nullptr);
}

__device__ __forceinline__ float dot128_bf(const LAS float* q, const bf16* krow) {
    float s0 = 0.f, s1 = 0.f;
#pragma unroll 1
    for (int c4 = 0; c4 < 16; c4 += 4) {
#pragma unroll
        for (int cc = 0; cc < 4; ++cc) { const int c = c4 + cc; const v4u kk = *(const v4u*)(krow + 8 * c); const f32x4 qa = *(const LAS f32x4*)(q + 8 * c), qb = *(const LAS f32x4*)(q + 8 * c + 4);
            s0 = fmaf(qa.x, blo(kk.x), s0); s1 = fmaf(qa.y, bhi(kk.x), s1); s0 = fmaf(qa.z, blo(kk.y), s0); s1 = fmaf(qa.w, bhi(kk.y), s1);
            s0 = fmaf(qb.x, blo(kk.z), s0); s1 = fmaf(qb.y, bhi(kk.z), s1); s0 = fmaf(qb.z, blo(kk.w), s0); s1 = fmaf(qb.w, bhi(kk.w), s1); } }
    return s0 + s1;
}
__device__ __forceinline__ float dot128_f(const LAS float* q, const float* krow) {
    float s0 = 0.f, s1 = 0.f;
#pragma unroll 1
    for (int c8 = 0; c8 < 32; c8 += 8) {
#pragma unroll
        for (int cc = 0; cc < 8; ++cc) { const int c = c8 + cc; const f32x4 kk = *(const f32x4*)(krow + 4 * c), qa = *(const LAS f32x4*)(q + 4 * c);
            s0 = fmaf(qa.x, kk.x, s0); s1 = fmaf(qa.y, kk.y, s1); s0 = fmaf(qa.z, kk.z, s0); s1 = fmaf(qa.w, kk.w, s1); } }
    return s0 + s1;
}
__device__ __forceinline__ void load_q(LAS float* qs, const bf16* qrow, int lane) {
    const unsigned w = *(const unsigned*)(qrow + 2 * lane); qs[2 * lane] = blo(w); qs[2 * lane + 1] = bhi(w); LDS_WAIT(); asm volatile("" ::: "memory");
}
struct SmState { float m, l, o0, o1; };
__device__ __forceinline__ void sm_chunk(SmState& S, float s, const bf16* vrow0, long vstep, int nk, LAS float* ps, int lane) {
    const float mx = wave_max(s), mn = fmaxf(S.m, mx), alpha = ex2(S.m - mn), p = ex2(s - mn);
    S.l = S.l * alpha + wave_sum(p); S.o0 *= alpha; S.o1 *= alpha; S.m = mn;
    asm volatile("" ::: "memory"); ps[lane] = p; LDS_WAIT(); asm volatile("" ::: "memory");
#pragma unroll 4
    for (int k = 0; k < nk; ++k) { const float pk = ps[k]; const unsigned w = *(const unsigned*)(vrow0 + (long)k * vstep + 2 * lane); S.o0 = fmaf(pk, blo(w), S.o0); S.o1 = fmaf(pk, bhi(w), S.o1); }
    LDS_WAIT(); asm volatile("" ::: "memory");
}
__device__ __forceinline__ void compress_item(const Frame& F, const Ctx& C, int L, int item) {
    const int lane = C.lane, tid = C.tid;
    const int ten = item >> 5, rg = item & 31;
    const float* w1 = PIN(ten ? 11 : 9) + (size_t)L * 8192 * 256; const float* w2 = PIN(ten ? 12 : 10) + (size_t)L * 256 * 128;
    const float* pe = PIN(ten ? 8 : 7) + (size_t)L * 8192; const int ccol = ten ? C_VC : C_KC;
    const bf16* PROJ = PWS(bf16, WS_PROJ); float* KC = PWS(float, WS_KC);
    float acc[8][4];
#pragma unroll
    for (int i = 0; i < 8; ++i)
#pragma unroll
        for (int jb = 0; jb < 4; ++jb) acc[i][jb] = 0.f;
    for (int k0 = C.wave * 1024; k0 < C.wave * 1024 + 1024; k0 += 64) {
        const int tok = k0 >> 7, d = (k0 & 127) + lane; float a[8];
#pragma unroll
        for (int i = 0; i < 8; ++i) { const int r = rg * 8 + i, g = r & 1, n = (r >> 1) & 63, b = r >> 7;
            a[i] = bf2f(PROJ[(size_t)(b * SEQ + n * 64 + tok) * NP + ccol + g * 128 + d]) + pe[k0 + lane]; }
#pragma unroll 4
        for (int kk = 0; kk < 64; ++kk) { const float* wr = w1 + (size_t)(k0 + kk) * 256 + lane; float wv[4];
#pragma unroll
            for (int jb = 0; jb < 4; ++jb) wv[jb] = wr[64 * jb];
#pragma unroll
            for (int i = 0; i < 8; ++i) { const float ai = __shfl(a[i], kk);
#pragma unroll
                for (int jb = 0; jb < 4; ++jb) acc[i][jb] = fmaf(ai, wv[jb], acc[i][jb]); } }
    }
    LAS float* red = (LAS float*)(C.lds + RING_OFF);
#pragma unroll
    for (int i = 0; i < 8; ++i)
#pragma unroll
        for (int jb = 0; jb < 4; ++jb) red[(C.wave * 8 + i) * 256 + jb * 64 + lane] = acc[i][jb];
    __syncthreads();
    LAS float* hid = red + 8 * 8 * 256;
    for (int e = tid; e < 8 * 256; e += NWAVES * 64) { float h = 0.f;
#pragma unroll
        for (int w = 0; w < 8; ++w) h += red[w * 2048 + e];
        hid[e] = h / (1.0f + __expf(-h)); }
    __syncthreads();
    { const int i = C.wave; float o0 = 0.f, o1 = 0.f;
        for (int j = 0; j < 256; ++j) { const float hv = hid[i * 256 + j]; o0 = fmaf(hv, w2[j * 128 + lane], o0); o1 = fmaf(hv, w2[j * 128 + 64 + lane], o1); }
        float* dst = KC + ((size_t)ten * 256 + rg * 8 + i) * 128; dst[lane] = o0; dst[64 + lane] = o1; }
    __syncthreads();
}
__device__ __forceinline__ void dil_item(const bf16* PROJ, bf16* OCAT, int it, LAS float* qs, LAS float* ps, int lane) {
    const int i = it & 3, t = (it >> 2) & (SEQ - 1), b = it >> 14; const size_t row = (size_t)b * SEQ + t;
    LAS float* og = qs + 256;
#pragma unroll 1
    for (int gi = 0; gi < 3; ++gi) { const int head = gi * 4 + i, dd = 1 << (2 * gi);
        load_q(qs, PROJ + row * NP + C_DQ + head * 128, lane);
        SmState S; S.m = -1e30f; S.l = 0.f; S.o0 = 0.f; S.o1 = 0.f;
#pragma unroll 1
        for (int c = 0; c < 3; ++c) { const int k = c * 64 + lane, key = t - k * dd; const bool valid = (k <= 128) && (key >= 0);
            float s = dot128_bf(qs, PROJ + ((size_t)b * SEQ + (valid ? key : t)) * NP + C_DK + head * 128); if (!valid) s = -__builtin_inff();
            int nk = 129 - c * 64; if (nk > 64) nk = 64; const int kmax = t / dd - c * 64 + 1; if (nk > kmax) nk = kmax;
            if (nk > 0) sm_chunk(S, s, PROJ + ((size_t)b * SEQ + (t - c * 64 * dd)) * NP + C_DV + head * 128, -(long)dd * NP, nk, ps, lane); }
        const float rl = 1.0f / S.l; og[gi * 128 + 2 * lane] = S.o0 * rl; og[gi * 128 + 2 * lane + 1] = S.o1 * rl; if (lane == 0) og[384 + gi] = S.m + lg2(S.l); }
    LDS_WAIT(); asm volatile("" ::: "memory");
    const float l0 = og[384], l1 = og[385], l2 = og[386], mx = fmaxf(l0, fmaxf(l1, l2));
    const float w0 = ex2(l0 - mx), w1 = ex2(l1 - mx), w2 = ex2(l2 - mx), rden = 1.0f / (w0 + w1 + w2);
#pragma unroll 1
    for (int gi = 0; gi < 3; ++gi) { const float al = (gi == 0 ? w0 : gi == 1 ? w1 : w2) * rden;
        *(unsigned*)(OCAT + row * DM + 1536 + (gi * 4 + i) * 128 + 2 * lane) = pk2(og[gi * 128 + 2 * lane] * al, og[gi * 128 + 2 * lane + 1] * al); }
    LDS_WAIT(); asm volatile("" ::: "memory");
}
__device__ __forceinline__ void sb_item(const bf16* PROJ, bf16* OCAT, int it, LAS float* qs, LAS float* ps, int lane) {
    const int h = it & 7, t = (it >> 3) & (SEQ - 1), b = it >> 15; const size_t row = (size_t)b * SEQ + t;
    load_q(qs, PROJ + row * NP + C_SQ + h * 128, lane);
    float R = 0.f, o0 = 0.f, o1 = 0.f;
#pragma unroll 1
    for (int c = 0; c * 64 < t; ++c) { const int key = t - 1 - (c * 64 + lane); const bool valid = key >= 0;
        const float z = dot128_bf(qs, PROJ + ((size_t)b * SEQ + (valid ? key : 0)) * NP + C_SK + h * 128);
        const float e = ex2(-fabsf(z)), lg = lg2(1.0f + e), lb = fminf(z, 0.f) - lg, l1m = valid ? (lb - z) : 0.f;
        float incl = l1m;
#pragma unroll
        for (int o = 1; o < 64; o <<= 1) { const float u = __shfl_up(incl, o); if (lane >= o) incl += u; }
        const float a = valid ? ex2(lb + R + (incl - l1m)) : 0.f;
        R += __shfl(incl, 63);
        asm volatile("" ::: "memory"); ps[lane] = a; LDS_WAIT(); asm volatile("" ::: "memory");
        int nk = t - c * 64; if (nk > 64) nk = 64;
        const bf16* v0 = PROJ + ((size_t)b * SEQ + (t - 1 - c * 64)) * NP + C_SV + h * 128 + 2 * lane;
#pragma unroll 4
        for (int k = 0; k < nk; ++k) { const float pk = ps[k]; const unsigned w = *(const unsigned*)(v0 - (long)k * NP); o0 = fmaf(pk, blo(w), o0); o1 = fmaf(pk, bhi(w), o1); }
        LDS_WAIT(); asm volatile("" ::: "memory"); }
    *(unsigned*)(OCAT + row * DM + 3072 + h * 128 + 2 * lane) = pk2(o0, o1);
}
__device__ __forceinline__ void cmp_item(const bf16* PROJ, const float* KC, float* OCMP, unsigned long long* SEL, int it, LAS float* qs, LAS float* ps, int lane) {
    const int t = it & (SEQ - 1), g = (it >> 12) & 1, b = it >> 13; const size_t row = (size_t)b * SEQ + t;
    const int nvalid = (t + 1) >> 6, cur = t >> 6; const bool valid = lane < nvalid; float imp = 0.f;
#pragma unroll 1
    for (int r = 0; r < 6; ++r) { const int h = g * 6 + r;
        load_q(qs, PROJ + row * NP + C_NQ + h * 128, lane);
        const float s = dot128_f(qs, KC + ((size_t)(b * 64 + lane) * 2 + g) * 128);
        float p = 0.f;
        if (nvalid > 0) { const float m = wave_max(valid ? s : -__builtin_inff()), e = valid ? ex2(s - m) : 0.f, l = wave_sum(e); p = e / l; }
        imp += p;
        asm volatile("" ::: "memory"); ps[lane] = p; LDS_WAIT(); asm volatile("" ::: "memory");
        float o0 = 0.f, o1 = 0.f;
#pragma unroll 4
        for (int n = 0; n < nvalid; ++n) { const float pn = ps[n]; const float2 v = *(const float2*)(KC + ((size_t)256 + (b * 64 + n) * 2 + g) * 128 + 2 * lane); o0 = fmaf(pn, v.x, o0); o1 = fmaf(pn, v.y, o1); }
        LDS_WAIT(); asm volatile("" ::: "memory");
        *(float2*)(OCMP + row * 1536 + h * 128 + 2 * lane) = make_float2(o0, o1); }
    const bool forced = (lane == 0) || (lane == cur) || (lane == cur - 1), started = lane <= cur;
    const float score = forced ? 7.0f : (started ? imp : -1.0f);
    int rank = 0;
#pragma unroll 8
    for (int i = 0; i < 64; ++i) { const float vi = __shfl(score, i); rank += ((vi > score) || (vi == score && i < lane)) ? 1 : 0; }
    const unsigned long long mask = __ballot(rank < 16);
    if (lane == 0) SEL[(size_t)(b * 2 + g) * SEQ + t] = mask;
}
__device__ __forceinline__ void nsa_item(const bf16* PROJ, const float* OCMP, const unsigned long long* SEL, bf16* OCAT, int it, LAS float* qs, LAS float* ps, int lane) {
    const int h = it % 12, bt = it / 12, t = bt & (SEQ - 1), b = bt >> 12, g = h / 6; const size_t row = (size_t)b * SEQ + t;
    const bf16* prow = PROJ + row * NP;
    load_q(qs, prow + C_NQ + h * 128, lane);
    const unsigned long long mask = SEL[(size_t)(b * 2 + g) * SEQ + t]; const int cur = t >> 6;
    SmState S; S.m = -1e30f; S.l = 0.f; S.o0 = 0.f; S.o1 = 0.f;
#pragma unroll 1
    for (int j = 0; j <= cur; ++j) { if (!((mask >> j) & 1ull)) continue;
        const int key = j * 64 + lane; float s = dot128_bf(qs, PROJ + ((size_t)b * SEQ + key) * NP + C_KS + g * 128); if (key > t) s = -__builtin_inff();
        int nk = t - j * 64 + 1; if (nk > 64) nk = 64;
        sm_chunk(S, s, PROJ + ((size_t)b * SEQ + j * 64) * NP + C_VS + g * 128, (long)NP, nk, ps, lane); }
    const float rs = 1.0f / S.l, os0 = S.o0 * rs, os1 = S.o1 * rs;
    S.m = -1e30f; S.l = 0.f; S.o0 = 0.f; S.o1 = 0.f;
    const int lowk = t - 511 > 0 ? t - 511 : 0;
#pragma unroll 1
    for (int kb = lowk & ~63; kb <= t; kb += 64) { const int key = kb + lane; const bool valid = key >= lowk && key <= t;
        float s = dot128_bf(qs, PROJ + ((size_t)b * SEQ + key) * NP + C_KW + g * 128); if (!valid) s = -__builtin_inff();
        int nk = t - kb + 1; if (nk > 64) nk = 64;
        sm_chunk(S, s, PROJ + ((size_t)b * SEQ + kb) * NP + C_VW + g * 128, (long)NP, nk, ps, lane); }
    const float rw = 1.0f / S.l, ow0 = S.o0 * rw, ow1 = S.o1 * rw;
    const float g0 = 1.0f / (1.0f + __expf(-bf2f(prow[C_GT + h * 3 + 0]))), g1 = 1.0f / (1.0f + __expf(-bf2f(prow[C_GT + h * 3 + 1]))), g2 = 1.0f / (1.0f + __expf(-bf2f(prow[C_GT + h * 3 + 2])));
    const float2 oc = *(const float2*)(OCMP + row * 1536 + h * 128 + 2 * lane);
    *(unsigned*)(OCAT + row * DM + h * 128 + 2 * lane) = pk2(g0 * oc.x + g1 * os0 + g2 * ow0, g0 * oc.y + g1 * os1 + g2 * ow1);
}

#define IN(k) (lo <= (k) && (k) < hi)
#define SEAM(k) do { if (IN(k) && IN((k) + 1)) { XcdBarrier b_; b_.bar = PWS(unsigned, WS_CTL) + CW_BAR + lo * XCD_BAR_WORDS; b_.x = xb_xcc_id(); b_.st = F.MISC + 8; xcd_barrier(b_); } } while (0)
#define QS ((LAS float*)(C.lds + RING_OFF + C.wave * 4096))
#define PS (QS + 128)
template <int L> __device__ __forceinline__ void layer_phases(const Frame& F, const int lo, const int hi) {
    constexpr int pb = 1 + 9 * L;
        if (IN(pb + 0)) {
            CTX();
            pg8::Gemm g{PWS(bf16, WS_H), PWS(bf16, WS_WIN) + (size_t)L * NP * DM, MTOK, NP, DM}; pg8::StaticOrder S; S.init(MTOK, NP, C.G, C.bid);
            pg8::EpiProj E{PWS(bf16, WS_PROJ), NP, PWS(float, WS_COS), PWS(float, WS_SIN), SEQ};
            pg8::gemm_phase<pg8::EpiProj, pg8::StaticOrder, true, true>(C.lds + RING_OFF, g, S, E, C.wave);
            SEAM(pb + 0);
        }
#ifndef NO_NAIVE
        if (IN(pb + 1)) {
            CTX();
#ifndef NO_CMPR
            for (int it = C.bid; it < 64; it += C.G) compress_item(F, C, L, it);
#endif
            const int lane = C.lane; const bf16* PROJ = PWS(bf16, WS_PROJ); bf16* OCAT = PWS(bf16, WS_OCAT);
#ifndef NO_DIL
            for (int it = C.gw; it < BATCH * SEQ * 4; it += C.ngw) dil_item(PROJ, OCAT, it, QS, PS, lane);
#endif
#ifndef NO_SB
            for (int it = C.gw; it < BATCH * SEQ * 8; it += C.ngw) sb_item(PROJ, OCAT, it, QS, PS, lane);
#endif
            SEAM(pb + 1);
        }
        if (IN(pb + 2)) {
            CTX();
            const int lane = C.lane; const bf16* PROJ = PWS(bf16, WS_PROJ); const float* KC = PWS(float, WS_KC); float* OCMP = PWS(float, WS_OCMP); unsigned long long* SEL = PWS(unsigned long long, WS_SEL);
#ifndef NO_CMP
            for (int it = C.gw; it < BATCH * 2 * SEQ; it += C.ngw) cmp_item(PROJ, KC, OCMP, SEL, it, QS, PS, lane);
#endif
            SEAM(pb + 2);
        }
        if (IN(pb + 3)) {
            CTX();
            const int lane = C.lane; const bf16* PROJ = PWS(bf16, WS_PROJ); const float* OCMP = PWS(float, WS_OCMP); const unsigned long long* SEL = PWS(unsigned long long, WS_SEL); bf16* OCAT = PWS(bf16, WS_OCAT);
#ifndef NO_NSA
            for (int it = C.gw; it < BATCH * SEQ * 12; it += C.ngw) nsa_item(PROJ, OCMP, SEL, OCAT, it, QS, PS, lane);
#endif
            SEAM(pb + 3);
        }
#endif
        if (IN(pb + 4)) {
            CTX();
            pg8::Gemm g{PWS(bf16, WS_OCAT), PWS(bf16, WS_WOUT) + (size_t)L * DM * DM, MTOK, DM, DM}; pg8::StaticOrder S; S.init(MTOK, DM, C.G, C.bid);
            float* X = PWS(float, WS_X); pg8::EpiResid E{L == 0 ? PIN(0) : X, X, DM};
            pg8::gemm_phase<pg8::EpiResid, pg8::StaticOrder, true, true>(C.lds + RING_OFF, g, S, E, C.wave);
            SEAM(pb + 4);
        }
        if (IN(pb + 5)) { CTX(); norm_phase(C, PWS(float, WS_X), PIN(4) + (size_t)L * DM, PWS(bf16, WS_H), nullptr); SEAM(pb + 5); }
        if (IN(pb + 6)) {
            CTX();
            pg8::Gemm g{PWS(bf16, WS_H), PWS(bf16, WS_WUP) + (size_t)L * DFF * DM, MTOK, DFF, DM}; pg8::StaticOrder S; S.init(MTOK, DFF, C.G, C.bid);
            pg8::EpiRelu2 E{PWS(bf16, WS_U), DFF};
            pg8::gemm_phase<pg8::EpiRelu2, pg8::StaticOrder, true, true>(C.lds + RING_OFF, g, S, E, C.wave);
            SEAM(pb + 6);
        }
        if (IN(pb + 7)) {
            CTX();
            pg8::Gemm g{PWS(bf16, WS_U), PWS(bf16, WS_WDN) + (size_t)L * DM * DFF, MTOK, DM, DFF}; pg8::StaticOrder S; S.init(MTOK, DM, C.G, C.bid);
            float* X = PWS(float, WS_X); pg8::EpiResid E{X, X, DM};
            pg8::gemm_phase<pg8::EpiResid, pg8::StaticOrder, true, true>(C.lds + RING_OFF, g, S, E, C.wave);
            SEAM(pb + 7);
        }
        if (IN(pb + 8)) {
            CTX();
            if (L + 1 < DEPTH) norm_phase(C, PWS(float, WS_X), PIN(3) + (size_t)(L + 1) * DM, PWS(bf16, WS_H), nullptr);
            else norm_phase(C, PWS(float, WS_X), PIN(13), nullptr, (float*)rd_ptr(F, PT_OUT));
            SEAM(pb + 8);
        }
}

struct Args { const float* in[14]; float* out; unsigned char* ws; int ph_lo, ph_hi; };
__global__ void __launch_bounds__(NWAVES * 64, 2) mega_fwd(Args args) {
    extern __shared__ __attribute__((aligned(16))) unsigned char lds[];
    Frame F;
    F.lds = (LAS unsigned char*)lds; F.MISC = (volatile LAS unsigned*)(F.lds + MISC_OFF);
    F.wave = __builtin_amdgcn_readfirstlane((int)(threadIdx.x >> 6));
    if (threadIdx.x < 64) ((LAS unsigned*)(F.lds + MISC_OFF))[threadIdx.x] = 0u;
    __syncthreads();
    if (threadIdx.x == 0) {
#pragma unroll
        for (int k = 0; k < 16; ++k) { const unsigned long long p = k < 14 ? (unsigned long long)args.in[k < 14 ? k : 0] : (k == 14 ? (unsigned long long)args.out : (unsigned long long)args.ws);
            F.MISC[16 + 2 * k] = (unsigned)p; F.MISC[17 + 2 * k] = (unsigned)(p >> 32); } }
    __syncthreads();
    const int lo = args.ph_lo, hi = args.ph_hi;
    (void)xcd_barrier_post(PWS(unsigned, WS_CTL) + CW_BAR + lo * XCD_BAR_WORDS, F.MISC + 8);

#ifndef NO_PRO
    if (IN(0)) { CTX(); p0_prologue(F, C); SEAM(0); }
#endif
    layer_phases<0>(F, lo, hi);
    layer_phases<1>(F, lo, hi);
}

extern "C" void kernel_launch(void* const* d_in, const int* in_sizes, int n_in, void* d_out, int out_size, void* d_ws, size_t ws_size, hipStream_t stream) {
    static int grid = 0;
    if (grid == 0) {
        if (n_in != 14 || in_sizes[0] != MTOK * DM || out_size != MTOK * DM || ws_size < WS_END) {
            fprintf(stderr, "kernel_launch: unexpected shapes (n_in %d, in0 %d, out %d, ws %zu; need ws >= %zu); nothing launched\n", n_in, n_in > 0 ? in_sizes[0] : -1, out_size, ws_size, (size_t)WS_END); grid = -1; return; }
        int dev = 0, cus = 0, per_cu = 0;
        if (hipGetDevice(&dev) != hipSuccess || hipDeviceGetAttribute(&cus, hipDeviceAttributeMultiprocessorCount, dev) != hipSuccess) { fprintf(stderr, "kernel_launch: device query failed\n"); grid = -1; return; }
        if (hipFuncSetAttribute((const void*)mega_fwd, hipFuncAttributeMaxDynamicSharedMemorySize, LDS_BYTES) != hipSuccess) { fprintf(stderr, "kernel_launch: hipFuncSetAttribute failed\n"); grid = -1; return; }
        if (hipOccupancyMaxActiveBlocksPerMultiprocessor(&per_cu, (const void*)mega_fwd, NWAVES * 64, LDS_BYTES) != hipSuccess || per_cu < 1)
            fprintf(stderr, "kernel_launch: note: occupancy query reports %d workgroups per CU\n", per_cu);
        (void)hipGetLastError();
        grid = cus;
    }
    if (grid < 0) return;
    if (hipMemsetAsync((char*)d_ws + WS_CTL, 0, CTL_ZERO_BYTES, stream) != hipSuccess) { fprintf(stderr, "kernel_launch: memset failed\n"); return; }
    Args a{};
    for (int i = 0; i < 14; ++i) a.in[i] = (const float*)d_in[i];
    a.out = (float*)d_out; a.ws = (unsigned char*)d_ws;
#if MK_ONE_LAUNCH
    a.ph_lo = 0; a.ph_hi = NPH;
    hipLaunchKernelGGL(mega_fwd, dim3(grid), dim3(NWAVES * 64), LDS_BYTES, stream, a);
#else
    for (int ph = 0; ph < NPH; ++ph) { a.ph_lo = ph; a.ph_hi = ph + 1;
        hipLaunchKernelGGL(mega_fwd, dim3(grid), dim3(NWAVES * 64), LDS_BYTES, stream, a); }
#endif
    const hipError_t le = hipPeekAtLastError();
    if (le != hipSuccess) fprintf(stderr, "kernel_launch: launch failed: %s\n", hipGetErrorName(le));
}
```

```cpp
#include <hip/hip_runtime.h>
#include <cstdio>
#include <cstdint>
#ifndef PROBE_SEC
#define PROBE_SEC 0
#endif
#ifndef NT_U
#define NT_U 0
#endif
constexpr float FX_SS = 16777216.0f, FX_SS_INV = 1.0f / 16777216.0f, FX_KC = 4294967296.0f, FX_KC_INV = 1.0f / 4294967296.0f;
__device__ __forceinline__ void fx_add(float* slot, float v, float scale) { atomicAdd((unsigned long long*)slot, (unsigned long long)__float2ll_rn(v * scale)); }
__device__ __forceinline__ void fx_put(float* slot, float v, float scale) { *(long long*)slot = __float2ll_rn(v * scale); }
__device__ __forceinline__ float fx_get(const float* slot, float inv) { return (float)(*(const long long*)slot) * inv; }
namespace pg8 {
#define PG8_LAS __attribute__((address_space(3)))
typedef unsigned short bf16_t;
typedef short bf16x8 __attribute__((ext_vector_type(8)));
typedef float f32x4 __attribute__((ext_vector_type(4)));
typedef unsigned u32x4 __attribute__((ext_vector_type(4)));
constexpr int BM = 256, BK = 64, HALF = 128, HTB = HALF * BK * 2  , STAGE_BYTES = 8 * HTB, NXCD = 8, WGM = 8;

__host__ __device__ __forceinline__ int lds_byte(int r, int c) { const int st = (r >> 4) * 2 + (c >> 5), rr = r & 15, cc = c & 31, ob = rr * 64 + cc * 2; return st * 1024 + (ob ^ (((ob >> 9) & 1) << 5)); }
__host__ __device__ __forceinline__ void stage_rc(int b, int& R, int& C) { const int st = b / 1024, sb = b % 1024, swz = sb ^ (((sb >> 9) & 1) << 5); R = (st >> 1) * 16 + swz / 64; C = (st & 1) * 32 + (swz % 64) / 2; }
__host__ __device__ __forceinline__ int perm32(int rho) { const int n = rho >> 4, i = rho & 15; return 8 * (i >> 2) + 4 * n + (i & 3); }

struct Unit { int pm, pn; };
struct Gemm { const bf16_t* A; const bf16_t* Bt; int M, N, K; };

struct StaticOrder {
    int nM, nN, nwg, G, c;
    __host__ __device__ void init(int M, int N, int G_, int c_) { nM = M / BM; nN = N / BM; nwg = nM * nN; G = G_; c = c_; }
    __host__ __device__ bool next(int i, Unit& u) const {
        const long L = (long)i * G + c; if (L >= nwg) return false;
        int wgid = (int)L; { const int q = nwg / NXCD, r = nwg % NXCD, xcd = wgid % NXCD, off = wgid / NXCD; wgid = (xcd < r ? xcd * (q + 1) : r * (q + 1) + (xcd - r) * q) + off; }
        const int nig = WGM * nN, gid = wgid / nig, fm = gid * WGM, gsz = (nM - fm) < WGM ? (nM - fm) : WGM;
        u.pm = fm + ((wgid % nig) % gsz); u.pn = (wgid % nig) / gsz; return true;
    }
    __device__ __forceinline__ void a_ready(const Unit&) const {}
    __device__ __forceinline__ void done(const Unit&) const {}
};

__device__ __forceinline__ unsigned cvt_pk_bf16(float lo, float hi) { unsigned r; asm volatile("v_cvt_pk_bf16_f32 %0, %1, %2" : "=v"(r) : "v"(lo), "v"(hi)); return r; }
typedef unsigned u32x2 __attribute__((ext_vector_type(2)));
constexpr float SCL2 = 0.12751743082459868f;
struct EpiProj {
    static constexpr bool PERM = true, AFTER_DRAIN = false;
    bf16_t* O; int ldc; const float* cosT; const float* sinT; int seq; const float* ss; bf16_t* kvc; int mtok; int pn0;
    __device__ __forceinline__ void operator()(const f32x4 (&acc)[2][2][4][2], const Unit& u, int wr, int wc, int fr, int fq) const {
        const int row0 = u.pm * BM + wr * 64 + fr, pn = u.pn + pn0;
        const bool scaled = (pn < 6) || (pn >= 9 && pn < 15) || (pn >= 30 && pn < 34);
        const float sc = scaled ? SCL2 : 1.0f;
        if (pn < 21) {
            const int j = 4 * wc + fq;
#pragma unroll
            for (int ai = 0; ai < 2; ++ai)
#pragma unroll
                for (int m = 0; m < 4; ++m) { const int row = row0 + ai * HALF + m * 16, t = row & (seq - 1); const float rs = sc * (1.0f / sqrtf(fx_get(ss + 2 * row, FX_SS_INV) * (1.0f / 4096.0f) + 1e-6f));
                    const f32x4 c4 = *(const f32x4*)(cosT + t * 64 + 4 * j), s4 = *(const f32x4*)(sinT + t * 64 + 4 * j);
                    const bool cmp_ = (pn == 7 || pn == 8);
                    bf16_t* rowp = cmp_ ? kvc + ((size_t)((pn - 7) * 2) * mtok + row) * 128 : O + (size_t)row * ldc + pn * BM; const size_t hstep_ = cmp_ ? (size_t)mtok * 128 : (size_t)HALF;
#pragma unroll
                    for (int bj = 0; bj < 2; ++bj) { const f32x4 x1 = acc[ai][bj][m][0] * rs, x2 = acc[ai][bj][m][1] * rs;
                        const f32x4 o1 = x1 * c4 - x2 * s4, o2 = x1 * s4 + x2 * c4;
                        u32x2 w1, w2; w1.x = cvt_pk_bf16(o1[0], o1[1]); w1.y = cvt_pk_bf16(o1[2], o1[3]); w2.x = cvt_pk_bf16(o2[0], o2[1]); w2.y = cvt_pk_bf16(o2[2], o2[3]);
                        *(u32x2*)(rowp + bj * hstep_ + 4 * j) = w1; *(u32x2*)(rowp + bj * hstep_ + 64 + 4 * j) = w2;
#if PROBE_SEC == 5
                        if (cmp_) { bf16_t* r2 = O + (size_t)row * ldc + pn * BM; *(u32x2*)(r2 + bj * HALF + 4 * j) = w1; *(u32x2*)(r2 + bj * HALF + 64 + 4 * j) = w2; }
#endif
                    } }
        } else {
            const int col0 = pn * BM + wc * 32 + 8 * fq;
#pragma unroll
            for (int ai = 0; ai < 2; ++ai)
#pragma unroll
                for (int m = 0; m < 4; ++m) { const int row = row0 + ai * HALF + m * 16; const bool cmp_ = (pn == 22 || pn == 23);
                    bf16_t* rowp = cmp_ ? kvc + ((size_t)((pn - 20) * 2) * mtok + row) * 128 + wc * 32 + 8 * fq : O + (size_t)row * ldc + col0; const size_t hstep_ = cmp_ ? (size_t)mtok * 128 : (size_t)HALF;
                    const float rs = sc * (1.0f / sqrtf(fx_get(ss + 2 * row, FX_SS_INV) * (1.0f / 4096.0f) + 1e-6f));
#pragma unroll
                    for (int bj = 0; bj < 2; ++bj) { const f32x4 v0 = acc[ai][bj][m][0] * rs, v1 = acc[ai][bj][m][1] * rs;
                        u32x4 w; w.x = cvt_pk_bf16(v0[0], v0[1]); w.y = cvt_pk_bf16(v0[2], v0[3]); w.z = cvt_pk_bf16(v1[0], v1[1]); w.w = cvt_pk_bf16(v1[2], v1[3]);
                        *(u32x4*)(rowp + bj * hstep_) = w;
#if PROBE_SEC == 5
                        if (cmp_) *(u32x4*)(O + (size_t)row * ldc + col0 + bj * HALF) = w;
#endif
                    } }
        }
    }
};
struct EpiResid {
    static constexpr bool PERM = false, AFTER_DRAIN = false;
    const float* base; float* out; int ldc; bf16_t* xb; float* ss;
    __device__ __forceinline__ void operator()(const f32x4 (&acc)[2][2][4][2], const Unit& u, int wr, int wc, int fr, int fq) const {
        const int row0 = u.pm * BM + wr * 64 + fr, col0 = u.pn * BM + wc * 32 + 4 * fq;
#pragma unroll
        for (int ai = 0; ai < 2; ++ai)
#pragma unroll
            for (int m = 0; m < 4; ++m) { const int row = row0 + ai * HALF + m * 16; const size_t off = (size_t)row * ldc + col0;
                f32x4 b[2][2]; float q = 0.f;
#pragma unroll
                for (int bj = 0; bj < 2; ++bj)
#pragma unroll
                    for (int n = 0; n < 2; ++n) b[bj][n] = *(const f32x4*)(base + off + bj * HALF + n * 16);
#pragma unroll
                for (int bj = 0; bj < 2; ++bj)
#pragma unroll
                    for (int n = 0; n < 2; ++n) { const f32x4 o = b[bj][n] + acc[ai][bj][m][n]; *(f32x4*)(out + off + bj * HALF + n * 16) = o;
                        if (xb) { u32x2 w; w.x = cvt_pk_bf16(o[0], o[1]); w.y = cvt_pk_bf16(o[2], o[3]); *(u32x2*)(xb + off + bj * HALF + n * 16) = w; q += (o[0] * o[0] + o[1] * o[1]) + (o[2] * o[2] + o[3] * o[3]); } }
                if (xb) { q += __shfl_xor(q, 16); q += __shfl_xor(q, 32); if (fq == 0) unsafeAtomicAdd(ss + row, q); }
                asm volatile("" ::: "memory"); }
    }
};
struct EpiResid2 {
    static constexpr bool PERM = true, AFTER_DRAIN = false;
    bf16_t* hi; bf16_t* lo; int ldc; float* ss; const float* base32;
    __device__ __forceinline__ void operator()(const f32x4 (&acc)[2][2][4][2], const Unit& u, int wr, int wc, int fr, int fq) const {
        const int row0 = u.pm * BM + wr * 64 + fr, col0 = u.pn * BM + wc * 32 + 8 * fq;
#pragma unroll
        for (int ai = 0; ai < 2; ++ai)
#pragma unroll
            for (int m = 0; m < 4; ++m) { const int row = row0 + ai * HALF + m * 16; const size_t off = (size_t)row * ldc + col0; float q = 0.f;
                u32x4 bh[2], bl[2];
                if (base32) {
#pragma unroll
                    for (int bj = 0; bj < 2; ++bj) { bh[bj] = *(const u32x4*)(base32 + off + bj * HALF); bl[bj] = *(const u32x4*)(base32 + off + bj * HALF + 4); }
                } else {
#pragma unroll
                    for (int bj = 0; bj < 2; ++bj) { bh[bj] = *(const u32x4*)(hi + off + bj * HALF); bl[bj] = *(const u32x4*)(lo + off + bj * HALF); } }
#pragma unroll
                for (int bj = 0; bj < 2; ++bj) { f32x4 v0 = acc[ai][bj][m][0], v1 = acc[ai][bj][m][1]; u32x4 wh, wl;
                    if (base32) { v0[0] += __uint_as_float(bh[bj].x); v0[1] += __uint_as_float(bh[bj].y); v0[2] += __uint_as_float(bh[bj].z); v0[3] += __uint_as_float(bh[bj].w);
                                  v1[0] += __uint_as_float(bl[bj].x); v1[1] += __uint_as_float(bl[bj].y); v1[2] += __uint_as_float(bl[bj].z); v1[3] += __uint_as_float(bl[bj].w);
                                  bh[bj] = (u32x4){0u, 0u, 0u, 0u}; bl[bj] = (u32x4){0u, 0u, 0u, 0u}; }
#define PG8_R2(V, E0, HW, LW, OH, OL) do { \
                    const float x0_ = (__uint_as_float(HW << 16) + __uint_as_float(LW << 16)) + V[E0], x1_ = (__uint_as_float(HW & 0xffff0000u) + __uint_as_float(LW & 0xffff0000u)) + V[E0 + 1]; \
                    q += x0_ * x0_ + x1_ * x1_; OH = cvt_pk_bf16(x0_, x1_); \
                    OL = cvt_pk_bf16(x0_ - __uint_as_float(OH << 16), x1_ - __uint_as_float(OH & 0xffff0000u)); } while (0)
                    PG8_R2(v0, 0, bh[bj].x, bl[bj].x, wh.x, wl.x); PG8_R2(v0, 2, bh[bj].y, bl[bj].y, wh.y, wl.y);
                    PG8_R2(v1, 0, bh[bj].z, bl[bj].z, wh.z, wl.z); PG8_R2(v1, 2, bh[bj].w, bl[bj].w, wh.w, wl.w);
#undef PG8_R2
                    *(u32x4*)(hi + off + bj * HALF) = wh; *(u32x4*)(lo + off + bj * HALF) = wl; }
                q += __shfl_xor(q, 16); q += __shfl_xor(q, 32); if (fq == 0) unsafeAtomicAdd(ss + row, q);
                asm volatile("" ::: "memory"); }
    }
};
struct EpiResidB {
    static constexpr bool PERM = true, AFTER_DRAIN = false;
    bf16_t* x; int ldc; float* ss; const float* base32;
    __device__ __forceinline__ void operator()(const f32x4 (&acc)[2][2][4][2], const Unit& u, int wr, int wc, int fr, int fq) const {
        const int row0 = u.pm * BM + wr * 64 + fr, col0 = u.pn * BM + wc * 32 + 8 * fq;
#pragma unroll
        for (int ai = 0; ai < 2; ++ai)
#pragma unroll
            for (int m = 0; m < 4; ++m) { const int row = row0 + ai * HALF + m * 16; const size_t off = (size_t)row * ldc + col0; float q = 0.f;
                f32x4 b0[2], b1[2];
                if (base32) {
#pragma unroll
                    for (int bj = 0; bj < 2; ++bj) { b0[bj] = __builtin_nontemporal_load((const f32x4*)(base32 + off + bj * HALF)); b1[bj] = __builtin_nontemporal_load((const f32x4*)(base32 + off + bj * HALF + 4)); }
                } else {
#pragma unroll
                    for (int bj = 0; bj < 2; ++bj) { const u32x4 w = __builtin_nontemporal_load((const u32x4*)(x + off + bj * HALF));
                        b0[bj] = (f32x4){__uint_as_float(w.x << 16), __uint_as_float(w.x & 0xffff0000u), __uint_as_float(w.y << 16), __uint_as_float(w.y & 0xffff0000u)};
                        b1[bj] = (f32x4){__uint_as_float(w.z << 16), __uint_as_float(w.z & 0xffff0000u), __uint_as_float(w.w << 16), __uint_as_float(w.w & 0xffff0000u)}; } }
#pragma unroll
                for (int bj = 0; bj < 2; ++bj) { const f32x4 v0 = b0[bj] + acc[ai][bj][m][0], v1 = b1[bj] + acc[ai][bj][m][1];
                    q += ((v0[0] * v0[0] + v0[1] * v0[1]) + (v0[2] * v0[2] + v0[3] * v0[3])) + ((v1[0] * v1[0] + v1[1] * v1[1]) + (v1[2] * v1[2] + v1[3] * v1[3]));
                    u32x4 w; w.x = cvt_pk_bf16(v0[0], v0[1]); w.y = cvt_pk_bf16(v0[2], v0[3]); w.z = cvt_pk_bf16(v1[0], v1[1]); w.w = cvt_pk_bf16(v1[2], v1[3]);
                    *(u32x4*)(x + off + bj * HALF) = w; }
                q += __shfl_xor(q, 16); q += __shfl_xor(q, 32); if (fq == 0) fx_add(ss + 2 * row, q, FX_SS);
                asm volatile("" ::: "memory"); }
    }
};
struct EpiRelu2 {
    static constexpr bool PERM = true, AFTER_DRAIN = false;
    bf16_t* O; int ldc; const float* ss;
    __device__ __forceinline__ void operator()(const f32x4 (&acc)[2][2][4][2], const Unit& u, int wr, int wc, int fr, int fq) const {
        const int row0 = u.pm * BM + wr * 64 + fr, col0 = u.pn * BM + wc * 32 + 8 * fq;
#pragma unroll
        for (int ai = 0; ai < 2; ++ai)
#pragma unroll
            for (int m = 0; m < 4; ++m) { const int row = row0 + ai * HALF + m * 16; bf16_t* rowp = O + (size_t)row * ldc + col0; const float r2 = 1.0f / (fx_get(ss + 2 * row, FX_SS_INV) * (1.0f / 4096.0f) + 1e-6f);
#pragma unroll
                for (int bj = 0; bj < 2; ++bj) { f32x4 v0 = acc[ai][bj][m][0], v1 = acc[ai][bj][m][1];
#pragma unroll
                    for (int e = 0; e < 4; ++e) { const float a = fmaxf(v0[e], 0.f), b = fmaxf(v1[e], 0.f); v0[e] = a * a * r2; v1[e] = b * b * r2; }
                    u32x4 w; w.x = cvt_pk_bf16(v0[0], v0[1]); w.y = cvt_pk_bf16(v0[2], v0[3]); w.z = cvt_pk_bf16(v1[0], v1[1]); w.w = cvt_pk_bf16(v1[2], v1[3]);
#if NT_U
                    __builtin_nontemporal_store(w, (u32x4*)(rowp + bj * HALF));
#else
                    *(u32x4*)(rowp + bj * HALF) = w;
#endif
                } }
    }
};

template <int MODE> struct MapOrder : StaticOrder {
    __host__ __device__ bool next(int i, Unit& u) const { if (!StaticOrder::next(i, u)) return false;
        u.pn = MODE == 1 ? u.pn + (u.pn >= 7 ? 2 : 0) + (u.pn >= 20 ? 1 : 0) : (u.pn == 0 ? 7 : u.pn == 1 ? 8 : 22); return true; }
};
template <class Epi, class Sched, bool ALIGN_EPI = false, bool SP2 = false>
__device__ __forceinline__ void gemm_phase(PG8_LAS unsigned char* lds, const Gemm g, const Sched& S, const Epi& E, const int wid_in) {
    int lane = (int)__builtin_amdgcn_mbcnt_hi(~0u, __builtin_amdgcn_mbcnt_lo(~0u, 0u)); asm volatile("" : "+v"(lane));
    const int wid = wid_in, tid = wid * 64 + lane, wr = wid >> 2, wc = wid & 3, fr = lane & 15, fq = lane >> 4;
    const int K = g.K, nt = K / BK;
    unsigned voffA[2], voffB[2];
#pragma unroll
    for (int i = 0; i < 2; ++i) { int R, C; stage_rc(tid * 16 + i * 8192, R, C); const int Rb = Epi::PERM ? ((R & ~31) + perm32(R & 31)) : R;
        voffA[i] = (unsigned)(R * K + C) * 2u; voffB[i] = (unsigned)(Rb * K + C) * 2u; }
    const size_t kstep = (size_t)(BK * 2);
    const size_t hstep = (size_t)HALF * K * 2;
    const size_t tstep = 2 * hstep;
    const unsigned ldsw = (unsigned)wid * 1024u;
    const int aoff = lds_byte(wr * 64 + fr, fq * 8), boff = lds_byte(wc * 32 + fr, fq * 8);
#define PG8_SA(b, h) (((b) * 2 + (h)) * HTB)
#define PG8_SB(b, h) ((4 + (b) * 2 + (h)) * HTB)
#define PG8_STAGE(bufoff, gbase, voff) do { _Pragma("unroll") for (int _i = 0; _i < 2; ++_i) \
        __builtin_amdgcn_global_load_lds((const unsigned*)((const char*)(gbase) + (voff)[_i]), (PG8_LAS unsigned*)(lds + (bufoff) + ldsw + _i * 8192), 16, 0, 0); } while (0)
#define PG8_LDA(dst, b, h) do { _Pragma("unroll") for (int m = 0; m < 4; ++m) _Pragma("unroll") for (int k = 0; k < 2; ++k) dst[m][k] = *(const PG8_LAS bf16x8*)(lds + PG8_SA(b, h) + aoff + m * 2048 + k * 1024); } while (0)
#define PG8_LDB(dst, b, h) do { _Pragma("unroll") for (int n = 0; n < 2; ++n) _Pragma("unroll") for (int k = 0; k < 2; ++k) dst[n][k] = *(const PG8_LAS bf16x8*)(lds + PG8_SB(b, h) + boff + n * 2048 + k * 1024); } while (0)
#define PG8_MMA(ai, bj, At, Bt) do { __builtin_amdgcn_s_setprio(1); _Pragma("unroll") for (int m = 0; m < 4; ++m) _Pragma("unroll") for (int n = 0; n < 2; ++n) _Pragma("unroll") for (int k = 0; k < 2; ++k) \
        acc[ai][bj][m][n] = __builtin_amdgcn_mfma_f32_16x16x32_bf16(Bt[n][k], At[m][k], acc[ai][bj][m][n], 0, 0, 0); __builtin_amdgcn_s_setprio(0); } while (0)
#define PG8_WAIT_V(n) asm volatile("s_waitcnt vmcnt(" #n ")" ::: "memory")
#define PG8_WAIT_L(n) asm volatile("s_waitcnt lgkmcnt(" #n ")" ::: "memory")
#define PG8_BAR __builtin_amdgcn_s_barrier()
#define PG8_SCHED __builtin_amdgcn_sched_barrier(0)
    Unit cur, nxt; int ui = 0;
    if (!S.next(0, cur)) return;
    f32x4 acc[2][2][4][2];
#pragma unroll
    for (int a = 0; a < 2; ++a)
#pragma unroll
        for (int b = 0; b < 2; ++b)
#pragma unroll
            for (int m = 0; m < 4; ++m)
#pragma unroll
                for (int n = 0; n < 2; ++n) acc[a][b][m][n] = (f32x4){0.f, 0.f, 0.f, 0.f};
    bf16x8 At[4][2], B0[2][2], B1[2][2];
    const char* cA = (const char*)g.A + (size_t)cur.pm * tstep; const char* cB = (const char*)g.Bt + (size_t)cur.pn * tstep;
    S.a_ready(cur);
    if constexpr (SP2) {
        PG8_STAGE(PG8_SB(0, 0), cB, voffB); PG8_STAGE(PG8_SB(0, 1), cB + hstep, voffB); PG8_STAGE(PG8_SA(0, 0), cA, voffA); PG8_STAGE(PG8_SA(0, 1), cA + hstep, voffA);
        if (wr == 1) PG8_BAR;
        PG8_WAIT_V(2); PG8_BAR;
        PG8_STAGE(PG8_SB(1, 0), cB + kstep, voffB); PG8_STAGE(PG8_SA(1, 0), cA + kstep, voffA); PG8_STAGE(PG8_SB(1, 1), cB + hstep + kstep, voffB);
        PG8_WAIT_V(6); PG8_BAR;
    } else {
        PG8_STAGE(PG8_SB(0, 0), cB, voffB); PG8_STAGE(PG8_SA(0, 0), cA, voffA); PG8_STAGE(PG8_SB(0, 1), cB + hstep, voffB); PG8_STAGE(PG8_SA(0, 1), cA + hstep, voffA);
        if (wr == 1) PG8_BAR;
        PG8_WAIT_V(4); PG8_BAR;
        PG8_STAGE(PG8_SB(1, 0), cB + kstep, voffB); PG8_STAGE(PG8_SA(1, 0), cA + kstep, voffA); PG8_STAGE(PG8_SB(1, 1), cB + hstep + kstep, voffB);
        PG8_WAIT_V(6); PG8_BAR;
    }
    for (;;) {
        const bool has_next = S.next(ui + 1, nxt);
        const char* nA = has_next ? (const char*)g.A + (size_t)nxt.pm * tstep : cA; const char* nB = has_next ? (const char*)g.Bt + (size_t)nxt.pn * tstep : cB;
        for (int t = 0; t < nt; t += 2) {
            const bool last = (t == nt - 2);
            const char* a1 = cA + (size_t)(t + 1) * kstep;
            const char* a2 = last ? nA : cA + (size_t)(t + 2) * kstep; const char* b2 = last ? nB : cB + (size_t)(t + 2) * kstep;
            const char* a3 = a2 + kstep; const char* b3 = b2 + kstep;
            if (last && has_next) S.a_ready(nxt);
            if constexpr (SP2) {
            PG8_LDB(B0, 0, 0); PG8_LDB(B1, 0, 1); PG8_SCHED; PG8_LDA(At, 0, 0); PG8_STAGE(PG8_SA(1, 1), a1 + hstep, voffA);
            PG8_WAIT_V(8); PG8_WAIT_L(0); PG8_BAR; PG8_MMA(0, 0, At, B0); PG8_MMA(0, 1, At, B1); PG8_BAR; PG8_SCHED;
            PG8_LDA(At, 0, 1); PG8_STAGE(PG8_SB(0, 0), b2, voffB); PG8_STAGE(PG8_SB(0, 1), b2 + hstep, voffB); PG8_STAGE(PG8_SA(0, 0), a2, voffA);
            PG8_WAIT_V(8); PG8_WAIT_L(0); PG8_BAR; PG8_MMA(1, 0, At, B0); PG8_MMA(1, 1, At, B1); PG8_BAR; PG8_SCHED;
            PG8_LDB(B0, 1, 0); PG8_LDB(B1, 1, 1); PG8_SCHED; PG8_LDA(At, 1, 0); PG8_STAGE(PG8_SA(0, 1), a2 + hstep, voffA);
            PG8_WAIT_V(8); PG8_WAIT_L(0); PG8_BAR; PG8_MMA(0, 0, At, B0); PG8_MMA(0, 1, At, B1); PG8_BAR; PG8_SCHED;
            PG8_LDA(At, 1, 1); PG8_STAGE(PG8_SB(1, 0), b3, voffB); PG8_STAGE(PG8_SB(1, 1), b3 + hstep, voffB); PG8_STAGE(PG8_SA(1, 0), a3, voffA);
            PG8_WAIT_V(8); PG8_WAIT_L(0); PG8_BAR; PG8_MMA(1, 0, At, B0); PG8_MMA(1, 1, At, B1); PG8_BAR; PG8_SCHED;
            } else {
            PG8_LDB(B0, 0, 0); PG8_SCHED; PG8_LDA(At, 0, 0); PG8_STAGE(PG8_SA(1, 1), a1 + hstep, voffA);
            PG8_WAIT_L(8); PG8_BAR; PG8_WAIT_L(0); PG8_MMA(0, 0, At, B0); PG8_BAR; PG8_SCHED;
            PG8_LDB(B1, 0, 1); PG8_STAGE(PG8_SB(0, 0), b2, voffB);
            PG8_BAR; PG8_WAIT_L(0); PG8_MMA(0, 1, At, B1); PG8_BAR;
            PG8_LDA(At, 0, 1); PG8_STAGE(PG8_SA(0, 0), a2, voffA);
            PG8_BAR; PG8_WAIT_L(0); PG8_MMA(1, 0, At, B0); PG8_BAR; PG8_SCHED;
            PG8_STAGE(PG8_SB(0, 1), b2 + hstep, voffB);
            PG8_WAIT_V(6); PG8_BAR; PG8_MMA(1, 1, At, B1); PG8_BAR;
            PG8_LDB(B0, 1, 0); PG8_SCHED; PG8_LDA(At, 1, 0); PG8_STAGE(PG8_SA(0, 1), a2 + hstep, voffA);
            PG8_WAIT_L(8); PG8_BAR; PG8_WAIT_L(0); PG8_MMA(0, 0, At, B0); PG8_BAR; PG8_SCHED;
            PG8_LDB(B1, 1, 1); PG8_STAGE(PG8_SB(1, 0), b3, voffB);
            PG8_BAR; PG8_WAIT_L(0); PG8_MMA(0, 1, At, B1); PG8_BAR;
            PG8_LDA(At, 1, 1); PG8_STAGE(PG8_SA(1, 0), a3, voffA);
            PG8_BAR; PG8_WAIT_L(0); PG8_MMA(1, 0, At, B0); PG8_BAR; PG8_SCHED;
            PG8_STAGE(PG8_SB(1, 1), b3 + hstep, voffB);
            PG8_WAIT_V(6); PG8_BAR; PG8_MMA(1, 1, At, B1); PG8_BAR;
            }
        }
        if constexpr (ALIGN_EPI) { if (wr == 0) PG8_BAR; }
        if constexpr (!Epi::AFTER_DRAIN) { E(acc, cur, wr, wc, fr, fq); S.done(cur); }
        if (!has_next) break;
#pragma unroll
        for (int a = 0; a < 2; ++a)
#pragma unroll
            for (int b = 0; b < 2; ++b)
#pragma unroll
                for (int m = 0; m < 4; ++m)
#pragma unroll
                    for (int n = 0; n < 2; ++n) acc[a][b][m][n] = (f32x4){0.f, 0.f, 0.f, 0.f};
        cur = nxt; cA = nA; cB = nB; ++ui;
        if constexpr (ALIGN_EPI) { if (wr == 1) PG8_BAR; }
    }
    PG8_WAIT_V(0);
    if constexpr (!ALIGN_EPI) { if (wr == 0) PG8_BAR; }
    PG8_BAR;
    if constexpr (Epi::AFTER_DRAIN) { E.fused(acc, cur, wr, wc, fr, fq, lds, wid, lane); S.done(cur); }
#undef PG8_SA
#undef PG8_SB
#undef PG8_STAGE
#undef PG8_LDA
#undef PG8_LDB
#undef PG8_MMA
#undef PG8_WAIT_V
#undef PG8_WAIT_L
#undef PG8_BAR
#undef PG8_SCHED
}
}
#define GAS __attribute__((address_space(1)))
#define LAS __attribute__((address_space(3)))
typedef unsigned short bf16;
typedef unsigned v4u __attribute__((ext_vector_type(4)));
typedef float f32x4 __attribute__((ext_vector_type(4)));
typedef short bf16x8 __attribute__((ext_vector_type(8)));
typedef GAS unsigned gu32;
typedef GAS unsigned long long gu64;
#define RLX_AGENT __ATOMIC_RELAXED, __HIP_MEMORY_SCOPE_AGENT
#define LDS_WAIT() asm volatile("s_waitcnt lgkmcnt(0)" ::: "memory")
#define VM_WAIT() asm volatile("s_waitcnt vmcnt(0)" ::: "memory")
__device__ __forceinline__ unsigned long long rt() { return __builtin_amdgcn_s_memrealtime(); }
__device__ __forceinline__ unsigned f2bf(float f) { unsigned u = __builtin_bit_cast(unsigned, f); return (u + 0x7fffu + ((u >> 16) & 1u)) >> 16; }
__device__ __forceinline__ unsigned pk2(float lo, float hi) { return f2bf(lo) | (f2bf(hi) << 16); }

#define XB_TMO      128
#define XB_XCNT(j)  (256  + 64 * (j))
#define XB_XSUB(j)  (1280 + 64 * (j))
#define XB_XGEN(j)  (2304 + 64 * (j))
#define XB_TOP      3328
#define XB_TOPGEN   3392
#define XCD_BAR_WORDS 3456
#define XB_SPIN_CAP (1u << 18)

__device__ __forceinline__ unsigned xb_ld(unsigned* p)              { return __hip_atomic_load(p, __ATOMIC_RELAXED, __HIP_MEMORY_SCOPE_AGENT); }
__device__ __forceinline__ unsigned xb_add(unsigned* p, unsigned v) { return __hip_atomic_fetch_add(p, v, __ATOMIC_RELAXED, __HIP_MEMORY_SCOPE_AGENT); }
__device__ __forceinline__ unsigned xb_xcc_id() { return (unsigned)__builtin_amdgcn_s_getreg((3 << 11) | 20) & 0xFu; }
#define XB_SPIN(cond, bar) do { unsigned _sp = 0; while (cond) { __builtin_amdgcn_s_sleep(1); \
    if ((++_sp & 255u) == 0u) { if (xb_ld(&(bar)[XB_TMO])) break; if (_sp > XB_SPIN_CAP) { atomicAdd(&(bar)[XB_TMO], 1u); break; } } } } while (0)

struct XcdBarrier {
    unsigned* bar; unsigned x;
    volatile LAS unsigned* st;
};

__device__ __forceinline__ XcdBarrier xcd_barrier_post(unsigned* bar, volatile LAS unsigned* st) {
    XcdBarrier b; b.bar = bar; b.x = xb_xcc_id(); b.st = st;
    if (threadIdx.x == 0) (void)xb_add(&bar[XB_XCNT(b.x)], 1u);
    return b;
}
__device__ __forceinline__ void xcd_barrier_complete(unsigned* bar, unsigned x, unsigned& nloc, unsigned& nx) {
    const unsigned G = gridDim.x * gridDim.y * gridDim.z;
    unsigned sum, cnt, mine, sp = 0u;
    for (;;) {
        sum = 0u; cnt = 0u; mine = 0u;
#pragma unroll
        for (unsigned j = 0; j < 16; ++j) { const unsigned c = xb_ld(&bar[XB_XCNT(j)]); sum += c; cnt += (c > 0u) ? 1u : 0u; mine = (j == x) ? c : mine; }
        if (sum == G) break;
        __builtin_amdgcn_s_sleep(1);
        if ((++sp & 255u) == 0u) { if (xb_ld(&bar[XB_TMO])) break; if (sp > XB_SPIN_CAP) { atomicAdd(&bar[XB_TMO], 1u); break; } }
    }
    nloc = mine > 0u ? mine : 1u; nx = cnt > 0u ? cnt : 1u;
}

__device__ __forceinline__ void xcd_barrier(const XcdBarrier& b) {
    asm volatile("s_waitcnt vmcnt(0)" ::: "memory");
    __syncthreads();
    if (threadIdx.x == 0) {
        unsigned* bar = b.bar;
        __builtin_amdgcn_s_waitcnt(0);
        unsigned nloc = b.st[0], nx = b.st[1];
        if (nloc == 0u) { xcd_barrier_complete(bar, b.x, nloc, nx); b.st[0] = nloc; b.st[1] = nx; }
        const unsigned old = xb_add(&bar[XB_XSUB(b.x)], 1u);
        const unsigned gen = old / nloc;
        if (old + 1u == (gen + 1u) * nloc) {
            __builtin_amdgcn_fence(__ATOMIC_RELEASE, "agent");
            asm volatile("s_waitcnt vmcnt(0)" ::: "memory");
            const unsigned og = xb_add(&bar[XB_TOP], 1u);
            const unsigned tg = og / nx;
            if (og + 1u == (tg + 1u) * nx) xb_add(&bar[XB_TOPGEN], 1u);
            else XB_SPIN(xb_ld(&bar[XB_TOPGEN]) == tg, bar);
            __builtin_amdgcn_fence(__ATOMIC_ACQUIRE, "agent");
            xb_add(&bar[XB_XGEN(b.x)], 1u);
            asm volatile("s_waitcnt vmcnt(0)" ::: "memory");
        } else {
            XB_SPIN(xb_ld(&bar[XB_XGEN(b.x)]) == gen, bar);
            __builtin_amdgcn_fence(__ATOMIC_ACQUIRE, "agent");
            asm volatile("s_waitcnt vmcnt(0)" ::: "memory");
        }
    }
    __syncthreads();
}

constexpr int NWAVES = 8;
#ifndef USE_FA_SB
#define USE_FA_SB 1
#endif
#ifndef USE_FA_DIL
#define USE_FA_DIL 1
#endif
#ifndef USE_FA_NSA
#define USE_FA_NSA 1
#endif
#ifndef PROBE_SEC
#define PROBE_SEC 0
#endif
#ifndef PROBE_C
#define PROBE_C 1000
#endif
#ifndef PROBE_BR
#define PROBE_BR 0
#endif
#define PBR(k) ((PROBE_BR == 0 || PROBE_BR == (k)) ? 1.0f : 0.0f)
#ifndef REP_PHASE
#define REP_PHASE -1
#endif
#define NREP(k) ((REP_PHASE == (k)) ? 2 : 1)
#ifndef PROBE_T
#define PROBE_T 0
#endif
#define PROBE_T0 0
#define PROBE_T1 1
#ifndef PROBE_K
#define PROBE_K 10
#endif
#define TS_BASE 100000
#define TSTAMP() do { if (PROBE_T) { if (threadIdx.x == 0) { const unsigned long long now_ = wall_clock64(); unsigned long long* tsb_ = (unsigned long long*)(rd_ptr(F, PT_WS)) + TS_BASE; \
        const unsigned long long prev_ = ((unsigned long long)F.MISC[49] << 32) | F.MISC[48]; const unsigned idx_ = F.MISC[50]; const unsigned long long d_ = now_ - prev_; \
        if (PROBE_T > 100 && PROBE_T != 999) atomicMax(tsb_ + 256 + idx_, d_); else atomicAdd(tsb_ + idx_, d_); F.MISC[48] = (unsigned)now_; F.MISC[49] = (unsigned)(now_ >> 32); F.MISC[50] = idx_ + 1u; } } } while (0)
#ifndef PROBE_N
#define PROBE_N 0
#endif
#ifndef NSA_REP_A
#define NSA_REP_A 1
#endif
#ifndef NSA_REP_B
#define NSA_REP_B 1
#endif
#ifndef NSA_REP_C
#define NSA_REP_C 1
#endif
#ifndef SPLIT_INPROJ
#define SPLIT_INPROJ 1
#endif
#ifndef DEFER_CONV
#define DEFER_CONV 1
#endif
#ifndef MK_ONE_LAUNCH
#define MK_ONE_LAUNCH 1
#endif
constexpr int BATCH = 2, SEQ = 4096, MTOK = BATCH * SEQ, DM = 4096, HD = 128, DFF = 16384, DEPTH = 2;
constexpr int NSRC = 10788, NP = 11008;
constexpr float RMS_EPS = 1e-6f;
constexpr int C_NQ = 0, C_KC = 1536, C_KS = 1792, C_KW = 2048, C_DQ = 2304, C_DK = 3840, C_VC = 5376, C_VS = 5632, C_VW = 5888, C_DV = 6144, C_SQ = 7680, C_SK = 8704, C_SV = 9728, C_GT = 10752;
constexpr size_t MiB = 1u << 20;
constexpr size_t WS_CTL = 0, CTL_ZERO_BYTES = 1 * MiB;
constexpr size_t WS_COS = 1 * MiB, WS_SIN = 2 * MiB, WS_KC = 3 * MiB, WS_KCB = 3 * MiB + 512 * 1024, WS_SEL = 4 * MiB, WS_LSE = 5 * MiB, WS_SS = 300 * 1024  , WS_PEP = 900 * 1024  , WS_W1T = 1488 * MiB  ;
constexpr size_t WS_WIN = 8 * MiB, WIN_L = (size_t)NP * DM * 2;
constexpr size_t WS_WOUT = 180 * MiB, WOUT_L = (size_t)DM * DM * 2;
constexpr size_t WS_WUP = 244 * MiB, WUP_L = (size_t)DFF * DM * 2;
constexpr size_t WS_WDN = 500 * MiB, WDN_L = (size_t)DM * DFF * 2;
constexpr size_t WS_H = 756 * MiB, WS_PROJ = 820 * MiB, WS_OCAT = 992 * MiB, WS_X = 1056 * MiB, WS_U = 1184 * MiB, WS_OCMP = 1440 * MiB, WS_KVC = 1504 * MiB  , WS_END = 1520 * MiB;
static_assert(WS_WIN + 2 * WIN_L <= WS_WOUT && WS_PROJ + (size_t)MTOK * NP * 2 <= WS_OCAT, "ws map");
constexpr int CW_TMO = 0, CW_CODE = 1, CW_BAR = 4096;
constexpr int NPH = 1 + 9 * DEPTH;
static_assert((CW_BAR + NPH * 3456) * 4 <= (int)CTL_ZERO_BYTES, "ctl");
constexpr int MISC_OFF = 0, RING_OFF = 1024, RING_BYTES = 131072, LDS_BYTES = 147456;

struct Frame {
    LAS unsigned char* lds; volatile LAS unsigned* MISC;
    int wave;
};
struct Ctx { LAS unsigned char* lds; int wave, lane, tid, G, bid, gw, ngw; };
#define CTX() Ctx C; do { int w_ = F.wave, g_ = (int)gridDim.x, b_ = (int)blockIdx.x; asm volatile("" : "+s"(w_), "+s"(g_), "+s"(b_)); C.lds = F.lds; C.wave = w_; C.G = g_; C.bid = b_; \
    C.gw = b_ * NWAVES + w_; C.ngw = g_ * NWAVES; C.lane = fresh_lane(); C.tid = w_ * 64 + C.lane; } while (0)
__device__ __forceinline__ int fresh_lane() { int l = (int)__builtin_amdgcn_mbcnt_hi(~0u, __builtin_amdgcn_mbcnt_lo(~0u, 0u)); asm volatile("" : "+v"(l)); return l; }
constexpr int PT_OUT = 14, PT_WS = 15;
__device__ __forceinline__ unsigned long long rd_ptr(const Frame& F, int k) {
    const unsigned lo = F.MISC[16 + 2 * k], hi = F.MISC[17 + 2 * k];
    return ((unsigned long long)(unsigned)__builtin_amdgcn_readfirstlane((int)hi) << 32) | (unsigned)__builtin_amdgcn_readfirstlane((int)lo);
}
#define PIN(k) ((const float*)rd_ptr(F, (k)))
#define PWS(T, off) ((T*)(rd_ptr(F, PT_WS) + (off)))
__device__ __forceinline__ float wave_sum(float v) {
#pragma unroll
    for (int o = 1; o < 64; o <<= 1) v += __shfl_xor(v, o);
    return v;
}
__device__ __forceinline__ float wave_max(float v) {
#pragma unroll
    for (int o = 1; o < 64; o <<= 1) v = fmaxf(v, __shfl_xor(v, o));
    return v;
}
__device__ __forceinline__ float bf2f(bf16 v) { return __uint_as_float((unsigned)v << 16); }
__device__ __forceinline__ float blo(unsigned w) { return __uint_as_float(w << 16); }
__device__ __forceinline__ float bhi(unsigned w) { return __uint_as_float(w & 0xffff0000u); }
__device__ __forceinline__ float ex2(float x) { return __builtin_amdgcn_exp2f(x); }
__device__ __forceinline__ float lg2(float x) { return __builtin_amdgcn_logf(x); }

__device__ __forceinline__ int il128(int d) { return ((d & 63) >> 2) * 8 + (d >> 6) * 4 + (d & 3); }
__device__ __forceinline__ int win_dest(int c) {
    if (c < 1536) return C_NQ + (c & ~127) + il128(c & 127);
    if (c < 3072) { const int e = c - 1536, seg = e >> 8, w = e & 255;
        const int base = seg == 0 ? C_KC : seg == 1 ? C_VC : seg == 2 ? C_KS : seg == 3 ? C_VS : seg == 4 ? C_KW : C_VW;
        return base + (w & ~127) + ((seg & 1) ? (w & 127) : il128(w & 127)); }
    if (c < 3108) return C_GT + (c - 3072);
    if (c < 4644) { const int e = c - 3108; return C_DQ + (e & ~127) + il128(e & 127); }
    if (c < 6180) { const int e = c - 4644; return C_DK + (e & ~127) + il128(e & 127); }
    if (c < 7716) return C_DV + (c - 6180);
    if (c < 8740) return C_SQ + (c - 7716);
    if (c < 9764) return C_SK + (c - 8740);
    return C_SV + (c - 9764);
}
template <bool MAPPED, bool PEDOT = false>
__device__ __forceinline__ void transpose_item(const float* W, int K, int N, bf16* WT, int kb, int nb, int lane, const float* pe = nullptr, float* pesum = nullptr, const float* gain = nullptr) {
    const int kr = lane >> 4, nq = lane & 15, k0 = 64 * kb + 16 * kr, n = 64 * nb + 4 * nq; const bool ok = n < N;
    const float* src = W + (size_t)k0 * N + (ok ? n : 0);
    f32x4 v[16];
#pragma unroll
    for (int i = 0; i < 16; ++i) v[i] = __builtin_nontemporal_load((const f32x4*)(src + (size_t)i * N));
    if (gain) {
#pragma unroll
        for (int i4 = 0; i4 < 4; ++i4) { const f32x4 g4 = *(const f32x4*)(gain + k0 + 4 * i4);
#pragma unroll
            for (int e = 0; e < 4; ++e) v[4 * i4 + e] *= g4[e]; } }
    if (ok) {
#pragma unroll
        for (int j = 0; j < 4; ++j) { const int dr = MAPPED ? win_dest(n + j) : n + j; v4u lo, hi;
            lo.x = pg8::cvt_pk_bf16(v[0][j], v[1][j]); lo.y = pg8::cvt_pk_bf16(v[2][j], v[3][j]); lo.z = pg8::cvt_pk_bf16(v[4][j], v[5][j]); lo.w = pg8::cvt_pk_bf16(v[6][j], v[7][j]);
            hi.x = pg8::cvt_pk_bf16(v[8][j], v[9][j]); hi.y = pg8::cvt_pk_bf16(v[10][j], v[11][j]); hi.z = pg8::cvt_pk_bf16(v[12][j], v[13][j]); hi.w = pg8::cvt_pk_bf16(v[14][j], v[15][j]);
            v4u* dst = (v4u*)(WT + (size_t)dr * K + k0); dst[0] = lo; dst[1] = hi; } }
    if (PEDOT) {
        f32x4 s = {0.f, 0.f, 0.f, 0.f};
#pragma unroll
        for (int i = 0; i < 16; ++i) s += pe[k0 + i] * v[i];
#pragma unroll
        for (int j = 0; j < 4; ++j) { float t = s[j]; t += __shfl_xor(t, 16); t += __shfl_xor(t, 32); if (kr == 0 && ok) fx_add(pesum + 2 * (n + j), t, FX_KC); } }
}
struct TrItem { const float* src; size_t N; const float* gain; bf16* WT; int K, k0, n; bool ok, mapped; };
__device__ __forceinline__ TrItem tr_make(const float* W, int K, int N, bf16* WT, int kb, int nb, int lane, const float* gain, bool mapped) {
    const int kr = lane >> 4, nq = lane & 15, k0 = 64 * kb + 16 * kr, n = 64 * nb + 4 * nq; const bool ok = n < N;
    TrItem t; t.src = W + (size_t)k0 * N + (ok ? n : 0); t.N = (size_t)N; t.gain = gain; t.WT = WT; t.K = K; t.k0 = k0; t.n = n; t.ok = ok; t.mapped = mapped; return t;
}
__device__ __forceinline__ void tr_load(f32x4 (&v)[16], const TrItem& t) {
#pragma unroll
    for (int i = 0; i < 16; ++i) v[i] = __builtin_nontemporal_load((const f32x4*)(t.src + (size_t)i * t.N));
}
__device__ __forceinline__ void tr_store(f32x4 (&v)[16], const TrItem& t) {
    if (t.gain) {
#pragma unroll
        for (int i4 = 0; i4 < 4; ++i4) { const f32x4 g4 = *(const f32x4*)(t.gain + t.k0 + 4 * i4);
#pragma unroll
            for (int e = 0; e < 4; ++e) v[4 * i4 + e] *= g4[e]; } }
    if (t.ok) {
#pragma unroll
        for (int j = 0; j < 4; ++j) { const int dr = t.mapped ? win_dest(t.n + j) : t.n + j; v4u lo, hi;
            lo.x = pg8::cvt_pk_bf16(v[0][j], v[1][j]); lo.y = pg8::cvt_pk_bf16(v[2][j], v[3][j]); lo.z = pg8::cvt_pk_bf16(v[4][j], v[5][j]); lo.w = pg8::cvt_pk_bf16(v[6][j], v[7][j]);
            hi.x = pg8::cvt_pk_bf16(v[8][j], v[9][j]); hi.y = pg8::cvt_pk_bf16(v[10][j], v[11][j]); hi.z = pg8::cvt_pk_bf16(v[12][j], v[13][j]); hi.w = pg8::cvt_pk_bf16(v[14][j], v[15][j]);
            v4u* dst = (v4u*)(t.WT + (size_t)dr * t.K + t.k0); dst[0] = lo; dst[1] = hi; } }
}
__device__ __forceinline__ void sincos_red(double x, double& s, double& c) {
    const double kd = rint(x * 0.63661977236758134308);
    double r = fma(-kd, 1.57079632679489655800e+00, x); r = fma(-kd, 6.12323399573676603587e-17, r);
    const int q = ((int)kd) & 3; const double r2 = r * r;
    const double sp = r * (1.0 + r2 * (-1.0 / 6 + r2 * (1.0 / 120 + r2 * (-1.0 / 5040 + r2 * (1.0 / 362880 + r2 * (-1.0 / 39916800 + r2 * (1.0 / 6227020800.0)))))));
    const double cp = 1.0 + r2 * (-0.5 + r2 * (1.0 / 24 + r2 * (-1.0 / 720 + r2 * (1.0 / 40320 + r2 * (-1.0 / 3628800 + r2 * (1.0 / 479001600.0 + r2 * (-1.0 / 87178291200.0)))))));
    s = (q == 0) ? sp : (q == 1) ? cp : (q == 2) ? -sp : -cp;
    c = (q == 0) ? cp : (q == 1) ? -sp : (q == 2) ? -cp : sp;
}
__device__ __forceinline__ void rms_row(const float* xrow, const float* g, bf16* ob, float* of, int lane) {
    const f32x4* xr = (const f32x4*)xrow + lane; f32x4 v[16]; float s = 0.f;
#pragma unroll
    for (int j = 0; j < 16; ++j) { v[j] = xr[64 * j]; s += (v[j].x * v[j].x + v[j].y * v[j].y) + (v[j].z * v[j].z + v[j].w * v[j].w); }
    const float rstd = 1.0f / sqrtf(wave_sum(s) * (1.0f / DM) + RMS_EPS);
    const f32x4* gr = (const f32x4*)g + lane;
#pragma unroll
    for (int j = 0; j < 16; ++j) { const f32x4 gv = gr[64 * j]; const f32x4 y = v[j] * rstd * gv;
        if (ob) ((unsigned long long*)ob)[lane + 64 * j] = (unsigned long long)pk2(y.x, y.y) | ((unsigned long long)pk2(y.z, y.w) << 32);
        else ((f32x4*)of)[lane + 64 * j] = y; }
}
__device__ __forceinline__ void raw_phase(const Ctx& C, const float* xin, bf16* ob, float* ss) {
    const int lane = C.lane;
    for (int m = C.gw; m < MTOK; m += C.ngw) { const f32x4* xr = (const f32x4*)(xin + (size_t)m * DM) + lane; float s = 0.f;
#pragma unroll
        for (int j = 0; j < 16; ++j) { const f32x4 v = __builtin_nontemporal_load(xr + 64 * j);     s += (v.x * v.x + v.y * v.y) + (v.z * v.z + v.w * v.w);
            ((unsigned long long*)(ob + (size_t)m * DM))[lane + 64 * j] = (unsigned long long)pg8::cvt_pk_bf16(v.x, v.y) | ((unsigned long long)pg8::cvt_pk_bf16(v.z, v.w) << 32); }
        s = wave_sum(s); if (lane == 0) fx_put(ss + 2 * m, s, FX_SS); }
}
__device__ __forceinline__ void norm_phase_b(const Ctx& C, const bf16* xin, const float* g, float* of) {
    const int lane = C.lane;
    for (int m = C.gw; m < MTOK; m += C.ngw) { const v4u* xr = (const v4u*)(xin + (size_t)m * DM) + lane; f32x4 y[16]; float s = 0.f;
#pragma unroll
        for (int j = 0; j < 8; ++j) { const v4u a = __builtin_nontemporal_load(xr + 64 * j);
            y[2 * j] = (f32x4){__uint_as_float(a.x << 16), __uint_as_float(a.x & 0xffff0000u), __uint_as_float(a.y << 16), __uint_as_float(a.y & 0xffff0000u)};
            y[2 * j + 1] = (f32x4){__uint_as_float(a.z << 16), __uint_as_float(a.z & 0xffff0000u), __uint_as_float(a.w << 16), __uint_as_float(a.w & 0xffff0000u)};
            s += ((y[2 * j].x * y[2 * j].x + y[2 * j].y * y[2 * j].y) + (y[2 * j].z * y[2 * j].z + y[2 * j].w * y[2 * j].w)) + ((y[2 * j + 1].x * y[2 * j + 1].x + y[2 * j + 1].y * y[2 * j + 1].y) + (y[2 * j + 1].z * y[2 * j + 1].z + y[2 * j + 1].w * y[2 * j + 1].w)); }
        const float rstd = 1.0f / sqrtf(wave_sum(s) * (1.0f / DM) + RMS_EPS);
        const f32x4* gr = (const f32x4*)g + 2 * lane; f32x4* orow = (f32x4*)(of + (size_t)m * DM) + 2 * lane;
#pragma unroll
        for (int j = 0; j < 8; ++j) { orow[128 * j] = y[2 * j] * rstd * gr[128 * j]; orow[128 * j + 1] = y[2 * j + 1] * rstd * gr[128 * j + 1]; } }
}
__device__ __forceinline__ void norm_phase(const Ctx& C, const float* xin, const float* g, bf16* ob, float* of) {
    const int lane = C.lane;
    for (int m = C.gw; m < MTOK; m += C.ngw) rms_row(xin + (size_t)m * DM, g, ob ? ob + (size_t)m * DM : nullptr, of ? of + (size_t)m * DM : nullptr, lane);
}

namespace fa {
typedef float f32x16 __attribute__((ext_vector_type(16)));
typedef short s16x4 __attribute__((ext_vector_type(4)));
typedef short bx8 __attribute__((ext_vector_type(8)));
typedef unsigned u32x4 __attribute__((ext_vector_type(4)));
typedef unsigned u32x2 __attribute__((ext_vector_type(2)));
constexpr int SHM_T = 16384;
constexpr int L_V = 0, L_K = 2 * SHM_T, L_WS = 4 * SHM_T;
constexpr int LDS_NEED = L_WS + 8192;
#define FA_KSWZ(row, colB) ((row) * 256 + ((colB) ^ (((row) & 15) << 4)))
__device__ __forceinline__ int v_st(int k, int c) { const int kk = (k & ~0xC) | ((k & 4) << 1) | ((k & 8) >> 1); return ((kk >> 3) * 4 + (c >> 5)) * 512 + ((kk & 7) * 32 + (c & 31)) * 2; }
__device__ __forceinline__ int v_rd_base(int lane) { return ((lane & 3) << 3) | (((lane >> 2) & 3) << 6) | (((lane >> 4) & 1) << 5) | (((lane >> 5) & 1) << 8); }
__device__ __forceinline__ int crow(int r, int hi) { return (r & 3) + 8 * (r >> 2) + 4 * hi; }
__device__ __forceinline__ unsigned cvtpk(float lo, float hi) { unsigned r; asm volatile("v_cvt_pk_bf16_f32 %0, %1, %2" : "=v"(r) : "v"(lo), "v"(hi)); return r; }
__device__ __forceinline__ float fadd_s(float a, float b) { float r; asm("v_add_f32 %0, %1, %2" : "=v"(r) : "v"(a), "v"(b)); return r; }
__device__ __forceinline__ float swap_max(float v) { auto rr = __builtin_amdgcn_permlane32_swap(__float_as_uint(v), __float_as_uint(v), false, false); return fmaxf(__uint_as_float(rr[0]), __uint_as_float(rr[1])); }
__device__ __forceinline__ float swap_sum(float v) { auto rr = __builtin_amdgcn_permlane32_swap(__float_as_uint(v), __float_as_uint(v), false, false); return __uint_as_float(rr[0]) + __uint_as_float(rr[1]); }
#define FA_PK4(P, B_, OUT) do { const unsigned a0_ = fa::cvtpk(P[B_ + 0], P[B_ + 1]), a1_ = fa::cvtpk(P[B_ + 2], P[B_ + 3]), b0_ = fa::cvtpk(P[B_ + 4], P[B_ + 5]), b1_ = fa::cvtpk(P[B_ + 6], P[B_ + 7]); \
        auto r0_ = __builtin_amdgcn_permlane32_swap(a0_, b0_, false, false); auto r1_ = __builtin_amdgcn_permlane32_swap(a1_, b1_, false, false); \
        fa::u32x4 w_ = {r0_[0], r1_[0], r0_[1], r1_[1]}; OUT = __builtin_bit_cast(fa::bx8, w_); } while (0)
struct Ids { int wid, lane, r32, hi, sr, sc, kws, vst0, vst1; };
__device__ __forceinline__ Ids make_ids(int wid, int lane) { Ids I; I.wid = wid; I.lane = lane; I.r32 = lane & 31; I.hi = lane >> 5; const int tid = wid * 64 + lane; I.sr = tid >> 4; I.sc = (tid & 15) * 8;
    I.kws = FA_KSWZ(I.sr, I.sc * 2); I.vst0 = v_st(I.sr, I.sc); I.vst1 = v_st(32 + I.sr, I.sc); return I; }
#define FA_G(T, p) ((const GAS T*)(p))
#define FA_GW(T, p) ((GAS T*)(p))
__device__ __forceinline__ Ids make_ids_op(int wid, int lane) { asm volatile("" : "+v"(lane)); return make_ids(wid, lane); }
struct Stage { bx8 k0, k1, v0, v1; };
__device__ __forceinline__ void stage_load(Stage& s, const bf16* Kt, const bf16* Vt, long pitch, const Ids& I) {
    s.v0 = *FA_G(bx8, Vt + (long)I.sr * pitch + I.sc); s.v1 = *FA_G(bx8, Vt + (long)(32 + I.sr) * pitch + I.sc);
    s.k0 = *FA_G(bx8, Kt + (long)I.sr * pitch + I.sc); s.k1 = *FA_G(bx8, Kt + (long)(32 + I.sr) * pitch + I.sc);
}
__device__ __forceinline__ void stage_write(const Stage& s, LAS unsigned char* lds, int buf, const Ids& I) {
    *(LAS bx8*)(lds + L_K + buf * SHM_T + I.kws) = s.k0; *(LAS bx8*)(lds + L_K + buf * SHM_T + I.kws + 32 * 256) = s.k1;
    *(LAS bx8*)(lds + L_V + buf * SHM_T + I.vst0) = s.v0; *(LAS bx8*)(lds + L_V + buf * SHM_T + I.vst1) = s.v1;
}
__device__ __forceinline__ void load_q(bx8 (&qr)[8], const bf16* qrow, int hi) {
#pragma unroll
    for (int d0 = 0; d0 < 8; ++d0) qr[d0] = *FA_G(bx8, qrow + d0 * 16 + hi * 8);
}
__device__ __forceinline__ void qkt(f32x16& p0, f32x16& p1, LAS const unsigned char* lds, int buf, const Ids& I, const bx8 (&qr)[8]) {
    p0 = f32x16{}; p1 = f32x16{};
    unsigned kb0 = (unsigned)(size_t)(lds + L_K + buf * SHM_T) + FA_KSWZ(I.r32, I.hi * 16); asm volatile("" : "+v"(kb0));
    const unsigned k0 = kb0, k1 = kb0 ^ 32u, k2 = kb0 ^ 64u, k3 = kb0 ^ 96u, k4 = kb0 ^ 128u, k5 = kb0 ^ 160u, k6 = kb0 ^ 192u, k7 = kb0 ^ 224u;
#define FA_KRD(dst, a, off) asm volatile("ds_read_b128 %0, %1 offset:%2" : "=&v"(dst) : "v"(a), "i"(off) : "memory")
#define FA_KW(n) do { asm volatile("s_waitcnt lgkmcnt(" #n ")" ::: "memory"); __builtin_amdgcn_sched_barrier(0); } while (0)
#define FA_KM(x0, x1, d0) do { p0 = __builtin_amdgcn_mfma_f32_32x32x16_bf16(x0, qr[d0], p0, 0, 0, 0); p1 = __builtin_amdgcn_mfma_f32_32x32x16_bf16(x1, qr[d0], p1, 0, 0, 0); } while (0)
    bx8 a0, a1, b0, b1, c0, c1;
    __builtin_amdgcn_sched_barrier(0);
    FA_KRD(a0, k0, 0); FA_KRD(a1, k0, 8192); FA_KRD(b0, k1, 0); FA_KRD(b1, k1, 8192); FA_KRD(c0, k2, 0); FA_KRD(c1, k2, 8192);
    FA_KW(4); FA_KM(a0, a1, 0); FA_KRD(a0, k3, 0);   FA_KRD(a1, k3, 8192);
    FA_KW(4); FA_KM(b0, b1, 1); FA_KRD(b0, k4, 0); FA_KRD(b1, k4, 8192);
    FA_KW(4); FA_KM(c0, c1, 2); FA_KRD(c0, k5, 0); FA_KRD(c1, k5, 8192);
    FA_KW(4); FA_KM(a0, a1, 3); FA_KRD(a0, k6, 0); FA_KRD(a1, k6, 8192);
    FA_KW(4); FA_KM(b0, b1, 4); FA_KRD(b0, k7, 0); FA_KRD(b1, k7, 8192);
    FA_KW(4); FA_KM(c0, c1, 5);
    FA_KW(2); FA_KM(a0, a1, 6);
    FA_KW(0); FA_KM(b0, b1, 7);
#undef FA_KM
#undef FA_KW
#undef FA_KRD
}
__device__ __forceinline__ void pvT(f32x16 (&o)[4], LAS const unsigned char* lds, int buf, const Ids& I, bx8 pa0, bx8 pa1, bx8 pa2, bx8 pa3) {
    const unsigned va = (unsigned)(size_t)(lds + L_V + buf * SHM_T) + (unsigned)v_rd_base(I.lane);
#define FA_TRRD(dst, off) asm volatile("ds_read_b64_tr_b16 %0, %1 offset:%2" : "=&v"(dst) : "v"(va), "i"(off) : "memory")
#define FA_PV(d0) do { s16x4 l0, l1, l2, l3, h0, h1, h2, h3; constexpr int b_ = (d0) * 512; \
        FA_TRRD(l0, b_); FA_TRRD(h0, b_ + 2048); FA_TRRD(l1, b_ + 4096); FA_TRRD(h1, b_ + 6144); FA_TRRD(l2, b_ + 8192); FA_TRRD(h2, b_ + 10240); FA_TRRD(l3, b_ + 12288); FA_TRRD(h3, b_ + 14336); \
        asm volatile("s_waitcnt lgkmcnt(0)" ::: "memory"); __builtin_amdgcn_sched_barrier(0); \
        o[d0] = __builtin_amdgcn_mfma_f32_32x32x16_bf16((bx8){l0[0], l0[1], l0[2], l0[3], h0[0], h0[1], h0[2], h0[3]}, pa0, o[d0], 0, 0, 0); \
        o[d0] = __builtin_amdgcn_mfma_f32_32x32x16_bf16((bx8){l1[0], l1[1], l1[2], l1[3], h1[0], h1[1], h1[2], h1[3]}, pa1, o[d0], 0, 0, 0); \
        o[d0] = __builtin_amdgcn_mfma_f32_32x32x16_bf16((bx8){l2[0], l2[1], l2[2], l2[3], h2[0], h2[1], h2[2], h2[3]}, pa2, o[d0], 0, 0, 0); \
        o[d0] = __builtin_amdgcn_mfma_f32_32x32x16_bf16((bx8){l3[0], l3[1], l3[2], l3[3], h3[0], h3[1], h3[2], h3[3]}, pa3, o[d0], 0, 0, 0); } while (0)
    FA_PV(0); FA_PV(1); FA_PV(2); FA_PV(3);
#undef FA_PV
#undef FA_TRRD
}
__device__ __forceinline__ void store_oT(const f32x16 (&o)[4], float scale, bf16* orow, int hi) {
#pragma unroll
    for (int d0 = 0; d0 < 4; ++d0)
#pragma unroll
        for (int g4 = 0; g4 < 4; ++g4) { u32x2 w; w.x = cvtpk(o[d0][4 * g4] * scale, o[d0][4 * g4 + 1] * scale); w.y = cvtpk(o[d0][4 * g4 + 2] * scale, o[d0][4 * g4 + 3] * scale);
            *FA_GW(u32x2, orow + 32 * d0 + 8 * g4 + 4 * hi) = w; }
}

__device__ __forceinline__ void sb_unit(const bf16* PROJ, bf16* OCAT, int b, int h, int t0, LAS unsigned char* lds, const Ids& I) {
    const int tq = t0 + I.wid * 32 + I.r32;
    const size_t row = (size_t)b * SEQ + tq;
    bx8 qr[8]; load_q(qr, PROJ + row * NP + C_SQ + h * 128, I.hi);
    const bf16* Kh = PROJ + (size_t)b * SEQ * NP + C_SK + h * 128; const bf16* Vh = PROJ + (size_t)b * SEQ * NP + C_SV + h * 128;
    bx8 T0, T1, ONES;
#pragma unroll
    for (int e = 0; e < 8; ++e) { T0[e] = (8 * I.hi + e > I.r32) ? (short)0x3F80 : (short)0; T1[e] = (16 + 8 * I.hi + e > I.r32) ? (short)0x3F80 : (short)0; ONES[e] = (short)0x3F80; }
    f32x16 o[4] = {f32x16{}, f32x16{}, f32x16{}, f32x16{}};
    float R = 0.f; bool dead = false;
    const int jt = (t0 >> 6) + 3, NT = jt + 1;
    LAS unsigned* flags = (LAS unsigned*)(lds + L_WS);
    Stage st; stage_load(st, Kh + (size_t)(jt * 64) * NP, Vh + (size_t)(jt * 64) * NP, NP, I);
    asm volatile("s_waitcnt vmcnt(0)" ::: "memory"); stage_write(st, lds, 0, I);
    if (NT > 1) stage_load(st, Kh + (size_t)(jt * 64 - 64) * NP, Vh + (size_t)(jt * 64 - 64) * NP, NP, I);
    __syncthreads();
    const int wfirst = t0 + I.wid * 32;
    for (int it = 0; it < NT; ++it) { const int j = jt - it, buf = it & 1, kb = j * 64;
        if (it + 1 < NT) { asm volatile("s_waitcnt vmcnt(0)" ::: "memory"); stage_write(st, lds, buf ^ 1, I); }
        if (it + 2 < NT) stage_load(st, Kh + (size_t)(kb - 128) * NP, Vh + (size_t)(kb - 128) * NP, NP, I);
        if (kb < wfirst + 31 && !dead) {
            f32x16 p0, p1; qkt(p0, p1, lds, buf, I, qr);
            const bool diag = kb + 63 >= wfirst;
            bx8 lm0, lm1, lm2, lm3; float l1first;
#define FA_SB_ELEM(P, B_, KOFF) _Pragma("unroll") for (int r = 0; r < 8; ++r) { const float z = P[B_ + r]; const float e = ex2(-fabsf(z)), lg = lg2(1.0f + e); float lb = fminf(z, 0.f) - lg, l1 = lb - z; \
                if (diag && (kb + KOFF + crow(B_ + r, I.hi) >= tq)) { lb = -__builtin_inff(); l1 = 0.f; } P[B_ + r] = lb; l1v[r] = l1; }
            { float l1v[8]; FA_SB_ELEM(p0, 0, 0); l1first = l1v[0]; FA_PK4(l1v, 0, lm0); }
            { float l1v[8]; FA_SB_ELEM(p0, 8, 0); FA_PK4(l1v, 0, lm1); }
            { float l1v[8]; FA_SB_ELEM(p1, 0, 32); FA_PK4(l1v, 0, lm2); }
            { float l1v[8]; FA_SB_ELEM(p1, 8, 32); FA_PK4(l1v, 0, lm3); }
#undef FA_SB_ELEM
            f32x16 s0 = f32x16{}, s1 = f32x16{};
            s0 = __builtin_amdgcn_mfma_f32_32x32x16_bf16(T0, lm0, s0, 0, 0, 0); s0 = __builtin_amdgcn_mfma_f32_32x32x16_bf16(T1, lm1, s0, 0, 0, 0);
            s0 = __builtin_amdgcn_mfma_f32_32x32x16_bf16(ONES, lm2, s0, 0, 0, 0); s0 = __builtin_amdgcn_mfma_f32_32x32x16_bf16(ONES, lm3, s0, 0, 0, 0);
            s1 = __builtin_amdgcn_mfma_f32_32x32x16_bf16(T0, lm2, s1, 0, 0, 0); s1 = __builtin_amdgcn_mfma_f32_32x32x16_bf16(T1, lm3, s1, 0, 0, 0);
            const float tot = __shfl(s0[0] + l1first, I.r32);
#pragma unroll
            for (int r = 0; r < 16; ++r) { p0[r] = ex2(p0[r] + R + s0[r]); p1[r] = ex2(p1[r] + R + s1[r]); }
            R += tot;
            bx8 pa0, pa1, pa2, pa3; FA_PK4(p0, 0, pa0); FA_PK4(p0, 8, pa1); FA_PK4(p1, 0, pa2); FA_PK4(p1, 8, pa3);
            pvT(o, lds, buf, I, pa0, pa1, pa2, pa3);
            dead = __all(R < -160.f) != 0;
        }
        if (I.lane == 0) flags[(it & 1) * 8 + I.wid] = dead ? 1u : 0u;
        __syncthreads();
        const u32x4 f0 = *(LAS const u32x4*)(flags + (it & 1) * 8), f1 = *(LAS const u32x4*)(flags + (it & 1) * 8 + 4);
        if ((f0.x & f0.y & f0.z & f0.w & f1.x & f1.y & f1.z & f1.w) != 0u) break;
    }
    store_oT(o, 1.0f, OCAT + row * DM + 3072 + h * 128, I.hi);
    __syncthreads();
}

template <bool SEL>
__device__ __forceinline__ void sm_tiles(f32x16 (&o)[4], float& m, float& l, const bx8 (&qr)[8], const bf16* Kh, const bf16* Vh, long pitch, int j_lo, int j_hi,
                                         int pq, int wfirst, unsigned W, unsigned long long selmask, LAS unsigned char* lds, const Ids& I) {
    const int NT = j_hi - j_lo + 1;
#define FA_KT(t) (Kh + (long)((j_lo + (t)) * 64) * pitch)
#define FA_VT(t) (Vh + (long)((j_lo + (t)) * 64) * pitch)
#define FA_ACT(t) ((((j_lo + (t)) * 64) <= wfirst + 31) && ((long)((j_lo + (t)) * 64) + 63 >= (long)wfirst - (long)(W - 1u)) && (!SEL || (__any((((selmask >> (j_lo + (t))) & 1ull) != 0ull) ? 1 : 0) != 0)))
    Stage st; { Stage s0; stage_load(s0, FA_KT(0), FA_VT(0), pitch, I);
        if (NT > 1) stage_load(st, FA_KT(1), FA_VT(1), pitch, I);
        asm volatile("s_waitcnt vmcnt(0)" ::: "memory"); stage_write(s0, lds, 0, I); }
    if (NT > 1) { *(LAS bx8*)(lds + L_K + SHM_T + I.kws) = st.k0; *(LAS bx8*)(lds + L_K + SHM_T + I.kws + 32 * 256) = st.k1; }
    if (NT > 2) { st.k0 = *FA_G(bx8, FA_KT(2) + (long)I.sr * pitch + I.sc); st.k1 = *FA_G(bx8, FA_KT(2) + (long)(32 + I.sr) * pitch + I.sc); }
    __syncthreads();
    f32x16 pA0, pA1, pB0, pB1; bool actA = FA_ACT(0), actB = false;
    if (actA) qkt(pA0, pA1, lds, 0, I, qr);
    __syncthreads();
#define FA_TRIP(PX0, PX1, actX, PY0, PY1, actY, it) do { const int j_ = j_lo + (it), buf_ = (it) & 1, kb_ = j_ * 64; \
        if ((it) + 1 < NT) { asm volatile("s_waitcnt vmcnt(0)" ::: "memory"); \
            *(LAS bx8*)(lds + L_V + (buf_ ^ 1) * SHM_T + I.vst0) = st.v0; *(LAS bx8*)(lds + L_V + (buf_ ^ 1) * SHM_T + I.vst1) = st.v1; \
            if ((it) + 2 < NT) { *(LAS bx8*)(lds + L_K + buf_ * SHM_T + I.kws) = st.k0; *(LAS bx8*)(lds + L_K + buf_ * SHM_T + I.kws + 32 * 256) = st.k1; } } \
        if ((it) + 2 < NT) { st.v0 = *FA_G(bx8, FA_VT((it) + 2) + (long)I.sr * pitch + I.sc); st.v1 = *FA_G(bx8, FA_VT((it) + 2) + (long)(32 + I.sr) * pitch + I.sc); } \
        if ((it) + 3 < NT) { st.k0 = *FA_G(bx8, FA_KT((it) + 3) + (long)I.sr * pitch + I.sc); st.k1 = *FA_G(bx8, FA_KT((it) + 3) + (long)(32 + I.sr) * pitch + I.sc); } \
        actY = ((it) + 1 < NT) && FA_ACT((it) + 1); \
        if (actY) qkt(PY0, PY1, lds, buf_ ^ 1, I, qr); \
        if (actX) { \
            const bool rsel_ = SEL ? (((selmask >> j_) & 1ull) != 0ull) : true; \
            const bool edge_ = (kb_ + 63 > wfirst) || ((long)kb_ < (long)wfirst + 31 - (long)(W - 1u)); \
            if (edge_) { const int dq_ = pq - kb_ - 4 * I.hi; const float NEG_ = -__builtin_inff(); \
                _Pragma("unroll") for (int r = 0; r < 16; ++r) { const int c_ = (r & 3) + 8 * (r >> 2); \
                    if ((unsigned)(dq_ - c_) >= W) PX0[r] = NEG_; if ((unsigned)(dq_ - c_ - 32) >= W) PX1[r] = NEG_; } } \
            float mx_ = PX0[0]; \
            _Pragma("unroll") for (int r = 1; r < 16; ++r) mx_ = fmaxf(mx_, PX0[r]); \
            _Pragma("unroll") for (int r = 0; r < 16; ++r) mx_ = fmaxf(mx_, PX1[r]); \
            mx_ = swap_max(mx_); if (SEL && !rsel_) mx_ = -__builtin_inff(); \
            if (__any(mx_ > m + 8.0f)) { const float mn_ = fmaxf(m, mx_), alpha_ = ex2(m - mn_); m = mn_; l *= alpha_; \
                _Pragma("unroll") for (int d0 = 0; d0 < 4; ++d0) _Pragma("unroll") for (int r = 0; r < 16; ++r) o[d0][r] *= alpha_; } \
            const float mref_ = (SEL && !rsel_) ? __builtin_inff() : m; float ps_ = 0.f; \
            PX0 = PX0 - mref_; PX1 = PX1 - mref_;     \
            _Pragma("unroll") for (int r = 0; r < 16; ++r) { PX0[r] = ex2(PX0[r]); PX1[r] = ex2(PX1[r]); } \
            { float s_[16];     \
              _Pragma("unroll") for (int r = 0; r < 16; ++r) s_[r] = fadd_s(PX0[r], PX1[r]); \
              _Pragma("unroll") for (int r = 0; r < 8; ++r) s_[r] = fadd_s(s_[r], s_[r + 8]); \
              _Pragma("unroll") for (int r = 0; r < 4; ++r) s_[r] = fadd_s(s_[r], s_[r + 4]); \
              ps_ = fadd_s(fadd_s(s_[0], s_[2]), fadd_s(s_[1], s_[3])); } \
            l += swap_sum(ps_); \
            bx8 pa0_, pa1_, pa2_, pa3_; FA_PK4(PX0, 0, pa0_); FA_PK4(PX0, 8, pa1_); FA_PK4(PX1, 0, pa2_); FA_PK4(PX1, 8, pa3_); \
            pvT(o, lds, buf_, I, pa0_, pa1_, pa2_, pa3_); } \
        __syncthreads(); } while (0)
    int it = 0;
    for (; it + 1 < NT; it += 2) { FA_TRIP(pA0, pA1, actA, pB0, pB1, actB, it); FA_TRIP(pB0, pB1, actB, pA0, pA1, actA, it + 1); }
    if (it < NT) FA_TRIP(pA0, pA1, actA, pB0, pB1, actB, it);
#undef FA_TRIP
#undef FA_KT
#undef FA_VT
#undef FA_ACT
}
__device__ __forceinline__ void dil_unit(const bf16* PROJ, bf16* OCAT, float* LSE, int b, int head, int dd, int res, int m0, LAS unsigned char* lds, const Ids& I) {
    const int mq = m0 + I.wid * 32 + I.r32; const size_t row = (size_t)b * SEQ + (size_t)mq * dd + res;
    bx8 qr[8]; load_q(qr, PROJ + row * NP + C_DQ + head * 128, I.hi);
    const bf16* Kh = PROJ + ((size_t)b * SEQ + res) * NP + C_DK + head * 128; const bf16* Vh = PROJ + ((size_t)b * SEQ + res) * NP + C_DV + head * 128;
    f32x16 o[4] = {f32x16{}, f32x16{}, f32x16{}, f32x16{}}; float m = -1e30f, l = 0.f;
    const int j_lo = m0 >= 128 ? (m0 - 128) >> 6 : 0, j_hi = (m0 + 255) >> 6;
    sm_tiles<false>(o, m, l, qr, Kh, Vh, (long)dd * NP, j_lo, j_hi, mq, m0 + I.wid * 32, 129u, 0ull, lds, I);
    store_oT(o, 1.0f / l, OCAT + row * DM + 1536 + head * 128, I.hi);
    if (I.hi == 0) *FA_GW(float, LSE + row * 12 + head) = m + lg2(l);
}
__device__ __forceinline__ void dil_fixup(bf16* OCAT, const float* LSE, int it, int lane) {
    const int i = it & 3; const size_t row = (size_t)(it >> 2);
    const float l0 = LSE[row * 12 + i], l1 = LSE[row * 12 + 4 + i], l2 = LSE[row * 12 + 8 + i], mx = fmaxf(l0, fmaxf(l1, l2));
    const float w0 = ex2(l0 - mx), w1 = ex2(l1 - mx), w2 = ex2(l2 - mx), rden = 1.0f / (w0 + w1 + w2);
#pragma unroll
    for (int gi = 0; gi < 3; ++gi) { unsigned* p = (unsigned*)(OCAT + row * DM + 1536 + (gi * 4 + i) * 128 + 2 * lane); const unsigned w = *p; const float al = (gi == 0 ? w0 : gi == 1 ? w1 : w2) * rden;
        *p = pk2(blo(w) * al, bhi(w) * al); }
}
constexpr int IMP_STRIDE = 68;
template <int MODE  >
__device__ __forceinline__ void acc_oT(const f32x16 (&o)[4], float scale, float* arow, bf16* orow, int hi) {
#pragma unroll
    for (int d0 = 0; d0 < 4; ++d0)
#pragma unroll
        for (int g4 = 0; g4 < 4; ++g4) { f32x4 v = {o[d0][4 * g4] * scale, o[d0][4 * g4 + 1] * scale, o[d0][4 * g4 + 2] * scale, o[d0][4 * g4 + 3] * scale};
            GAS f32x4* p = FA_GW(f32x4, arow + 32 * d0 + 8 * g4 + 4 * hi);
            if (MODE >= 1) v = v + *p;
            if (MODE <= 1) *p = v;
            else { u32x2 w; w.x = cvtpk(v[0], v[1]); w.y = cvtpk(v[2], v[3]); *FA_GW(u32x2, orow + 32 * d0 + 8 * g4 + 4 * hi) = w; } }
}
__device__ __forceinline__ void stage_kc(const float* KC, int b, int g, LAS unsigned char* lds, const Ids& I);
__device__ __forceinline__ void cmp_unit(const bf16* PROJ, const float* KC, float* ACC, unsigned long long* SEL, int b, int g, int t0, LAS unsigned char* lds, const Ids& I) {
    const int tq = t0 + I.wid * 32 + I.r32, wfirst = t0 + I.wid * 32; const size_t row = (size_t)b * SEQ + tq;
    const bf16* prow = PROJ + row * NP;
    stage_kc(KC, b, g, lds, I);
    __syncthreads();
    const int nvalid = (tq + 1) >> 6;
    f32x16 i0 = f32x16{}, i1 = f32x16{};
#pragma unroll 1
    for (int r6 = 0; r6 < 6; ++r6) { const int hh = g * 6 + r6;
        bx8 qr[8]; load_q(qr, prow + C_NQ + hh * 128, I.hi);
        f32x16 p0, p1; qkt(p0, p1, lds, 0, I, qr);
        const float NEG = -__builtin_inff(); float mx = NEG;
#pragma unroll
        for (int r = 0; r < 16; ++r) { if (crow(r, I.hi) >= nvalid) p0[r] = NEG; if (32 + crow(r, I.hi) >= nvalid) p1[r] = NEG; mx = fmaxf(mx, fmaxf(p0[r], p1[r])); }
        mx = swap_max(mx); const float mref = nvalid > 0 ? mx : 0.f; float ps = 0.f;
#pragma unroll
        for (int r = 0; r < 16; ++r) { p0[r] = ex2(p0[r] - mref); p1[r] = ex2(p1[r] - mref); ps += p0[r] + p1[r]; }
        ps = swap_sum(ps); const float rl = nvalid > 0 ? 1.0f / ps : 0.f;
#pragma unroll
        for (int r = 0; r < 16; ++r) { p0[r] *= rl; p1[r] *= rl; i0[r] += p0[r]; i1[r] += p1[r]; }
        bx8 ca0, ca1, ca2, ca3; FA_PK4(p0, 0, ca0); FA_PK4(p0, 8, ca1); FA_PK4(p1, 0, ca2); FA_PK4(p1, 8, ca3);
        f32x16 o[4] = {f32x16{}, f32x16{}, f32x16{}, f32x16{}};
        pvT(o, lds, 0, I, ca0, ca1, ca2, ca3);
        acc_oT<0>(o, PBR(1) * 1.0f / (1.0f + __expf(-bf2f(*FA_G(bf16, prow + C_GT + hh * 3 + 0)))), ACC + row * 1536 + hh * 128, nullptr, I.hi); }
    LAS float* imp = (LAS float*)(lds + L_WS) + (size_t)I.wid * 32 * IMP_STRIDE;
#pragma unroll
    for (int g4 = 0; g4 < 4; ++g4) { *(LAS f32x4*)(imp + I.r32 * IMP_STRIDE + 8 * g4 + 4 * I.hi) = (f32x4){i0[4 * g4], i0[4 * g4 + 1], i0[4 * g4 + 2], i0[4 * g4 + 3]};
        *(LAS f32x4*)(imp + I.r32 * IMP_STRIDE + 32 + 8 * g4 + 4 * I.hi) = (f32x4){i1[4 * g4], i1[4 * g4 + 1], i1[4 * g4 + 2], i1[4 * g4 + 3]}; }
    LDS_WAIT(); asm volatile("" ::: "memory");
#pragma unroll 1
    for (int tk = 0; tk < 32; ++tk) { const int t = wfirst + tk, cur = t >> 6, n = I.lane;
        const float v = imp[tk * IMP_STRIDE + n];
        const bool forced = (n == 0) || (n == cur) || (n == cur - 1), started = n <= cur;
        const float score = forced ? 7.0f : (started ? v : -1.0f);
        const int sb_ = (int)__float_as_uint(score); const unsigned key = sb_ < 0 ? 0u : (unsigned)sb_ + 1u;
        unsigned T = 0u;
#pragma unroll
        for (int bit = 31; bit >= 0; --bit) { const unsigned cand = T | (1u << bit); if (__popcll(__ballot(key >= cand)) >= 16) T = cand; }
        const unsigned long long gt = __ballot(key > T); unsigned long long eq = __ballot(key == T), mk = gt;
        for (int need = 16 - __popcll(gt); need > 0; --need) { const unsigned long long lowest = eq & (0ull - eq); mk |= lowest; eq ^= lowest; }
        if (n == 0) *FA_GW(unsigned long long, SEL + (size_t)(b * 2 + g) * SEQ + t) = mk; }
    __syncthreads();
}
__device__ __forceinline__ void nsa_unit(const bf16* PROJ, const bf16* KVC, const unsigned long long* SEL, float* ACC, bf16* OCAT, int b, int h, int t0, LAS unsigned char* lds, const Ids& I, volatile LAS unsigned* misc = nullptr) {
#define NACC(k) do { } while (0)
    const int g = h / 6, tq = t0 + I.wid * 32 + I.r32, wfirst = t0 + I.wid * 32;
    const unsigned long long selmask = *FA_G(unsigned long long, SEL + (size_t)(b * 2 + g) * SEQ + tq);
    NACC(0);
    bx8 qr[8]; { int tq_ = tq; asm volatile("" : "+v"(tq_)); load_q(qr, PROJ + ((size_t)b * SEQ + tq_) * NP + C_NQ + h * 128, I.hi); }
    const int j_hi = (t0 >> 6) + 3;
    for (int repb_ = 0; repb_ < NSA_REP_B; ++repb_)
    {
        float zs_ = (repb_ + 1 == NSA_REP_B) ? 1.0f : 0.0f; asm volatile("" : "+v"(zs_));
        f32x16 o[4] = {f32x16{}, f32x16{}, f32x16{}, f32x16{}}; float m = -1e30f, l = 0.f;
        sm_tiles<true>(o, m, l, qr, KVC + ((size_t)(0 + g) * MTOK + (size_t)b * SEQ) * 128, KVC + ((size_t)(4 + g) * MTOK + (size_t)b * SEQ) * 128, 128L, 0, j_hi, tq, wfirst, 0x7fffffffu, selmask, lds, I);
        int tq_ = tq; asm volatile("" : "+v"(tq_)); const size_t row_ = (size_t)b * SEQ + tq_;
        acc_oT<1>(o, zs_ * PBR(2) * (1.0f / (1.0f + __expf(-bf2f(*FA_G(bf16, PROJ + row_ * NP + C_GT + h * 3 + 1))))) / l, ACC + row_ * 1536 + h * 128, nullptr, I.hi);
    }
    NACC(1);
    for (int repc_ = 0; repc_ < NSA_REP_C; ++repc_)
    {
        float zs_ = (repc_ + 1 == NSA_REP_C) ? 1.0f : 0.0f; asm volatile("" : "+v"(zs_));
        f32x16 o[4] = {f32x16{}, f32x16{}, f32x16{}, f32x16{}}; float m = -1e30f, l = 0.f;
        const int j_lo = t0 >= 512 ? (t0 - 511) >> 6 : 0;
        sm_tiles<false>(o, m, l, qr, KVC + ((size_t)(2 + g) * MTOK + (size_t)b * SEQ) * 128, KVC + ((size_t)(6 + g) * MTOK + (size_t)b * SEQ) * 128, 128L, j_lo, j_hi, tq, wfirst, 512u, 0ull, lds, I);
        int tq_ = tq; asm volatile("" : "+v"(tq_)); const size_t row_ = (size_t)b * SEQ + tq_;
        if (repc_ + 1 < NSA_REP_C) acc_oT<1>(o, zs_ / l, ACC + row_ * 1536 + h * 128, nullptr, I.hi); else
        acc_oT<2>(o, PBR(3) * (1.0f / (1.0f + __expf(-bf2f(*FA_G(bf16, PROJ + row_ * NP + C_GT + h * 3 + 2))))) / l, ACC + row_ * 1536 + h * 128, OCAT + row_ * DM + h * 128, I.hi);
    }
    NACC(2);
#undef NACC
}

__device__ __forceinline__ void compress_unit(const bf16* PROJ, const bf16* W1t, const float* PEP, const float* w2, float* KC, int cu, LAS unsigned char* lds, const Ids& I, unsigned* done) {
    const int ten = cu >> 6, rt = (cu >> 3) & 7, ct = cu & 7, ccol = ten ? C_VC : C_KC;
    const int rowi = rt * 32 + I.r32, g = rowi & 1, n = (rowi >> 1) & 63, b = rowi >> 7;
    const bf16* arow = PROJ + ((size_t)b * SEQ + n * 64 + I.wid * 8) * NP + ccol + g * 128 + 8 * I.hi;
    const bf16* brow = W1t + ((size_t)ten * 256 + ct * 32 + I.r32) * 8192 + I.wid * 1024 + 8 * I.hi;
    f32x16 acc = f32x16{};
#pragma unroll 1
    for (int s8 = 0; s8 < 64; s8 += 8) {
        bx8 a[8], w[8];
#pragma unroll
        for (int s = 0; s < 8; ++s) { a[s] = *FA_G(bx8, arow + (size_t)(s8 >> 3) * NP + 16 * s); w[s] = *FA_G(bx8, brow + (s8 + s) * 16); }
#pragma unroll
        for (int s = 0; s < 8; ++s) acc = __builtin_amdgcn_mfma_f32_32x32x16_bf16(a[s], w[s], acc, 0, 0, 0);
    }
    LAS float* red = (LAS float*)lds;
#pragma unroll
    for (int r = 0; r < 16; ++r) red[(I.wid * 32 + crow(r, I.hi)) * 32 + I.r32] = acc[r];
    __syncthreads();
    LAS float* hid = red + 8 * 1024;
    LAS float* pew = hid + 32 * 33;
    const int tid = I.wid * 64 + I.lane;
    if (tid < 32) pew[tid] = fx_get(PEP + 2 * ((size_t)ten * 256 + ct * 32 + tid), FX_KC_INV);
    __syncthreads();
    for (int e = tid; e < 1024; e += 512) { float hsum = pew[e & 31];
#pragma unroll
        for (int w = 0; w < 8; ++w) hsum += red[w * 1024 + e];
        hid[(e >> 5) * 33 + (e & 31)] = hsum / (1.0f + __expf(-hsum)); }
    __syncthreads();
    { const int r = tid >> 4, dg = tid & 15; f32x4 o0 = {0.f, 0.f, 0.f, 0.f}, o1 = {0.f, 0.f, 0.f, 0.f};
#pragma unroll 8
        for (int c = 0; c < 32; ++c) { const float hv = hid[r * 33 + c]; const GAS f32x4* wp = FA_G(f32x4, w2 + (size_t)(ct * 32 + c) * 128 + 8 * dg); o0 += hv * wp[0]; o1 += hv * wp[1]; }
        float* dst = KC + 2 * (((size_t)ten * 256 + rt * 32 + r) * 128 + 8 * dg);
#pragma unroll
        for (int e = 0; e < 4; ++e) { fx_add(dst + 2 * e, o0[e], FX_KC); fx_add(dst + 2 * (4 + e), o1[e], FX_KC); } }
    asm volatile("s_waitcnt vmcnt(0)" ::: "memory");
    __syncthreads();
    if (tid == 0) { __builtin_amdgcn_fence(__ATOMIC_RELEASE, "agent"); asm volatile("s_waitcnt vmcnt(0)" ::: "memory");
        __hip_atomic_fetch_add(done, 1u, __ATOMIC_RELAXED, __HIP_MEMORY_SCOPE_AGENT); }
}
__device__ __forceinline__ void stage_kc(const float* KC, int b, int g, LAS unsigned char* lds, const Ids& I) {
    typedef long long ll2 __attribute__((ext_vector_type(2)));
    const float* kb = KC + 2 * (((size_t)(b * 64) * 2 + g) * 128 + I.sc); const float* vb = kb + 2 * ((size_t)256 * 128);
#define FA_KC4(name, p) f32x4 name; { const ll2 a_ = *FA_G(ll2, p), b_ = *FA_G(ll2, (p) + 4); name = (f32x4){(float)a_.x * FX_KC_INV, (float)a_.y * FX_KC_INV, (float)b_.x * FX_KC_INV, (float)b_.y * FX_KC_INV}; }
    FA_KC4(k00, kb + 2 * ((size_t)I.sr * 256)); FA_KC4(k01, kb + 2 * ((size_t)I.sr * 256 + 4)); FA_KC4(k10, kb + 2 * ((size_t)(32 + I.sr) * 256)); FA_KC4(k11, kb + 2 * ((size_t)(32 + I.sr) * 256 + 4));
    FA_KC4(v00, vb + 2 * ((size_t)I.sr * 256)); FA_KC4(v01, vb + 2 * ((size_t)I.sr * 256 + 4)); FA_KC4(v10, vb + 2 * ((size_t)(32 + I.sr) * 256)); FA_KC4(v11, vb + 2 * ((size_t)(32 + I.sr) * 256 + 4));
#undef FA_KC4
    Stage st;
    { u32x4 w = {cvtpk(k00[0], k00[1]), cvtpk(k00[2], k00[3]), cvtpk(k01[0], k01[1]), cvtpk(k01[2], k01[3])}; st.k0 = __builtin_bit_cast(bx8, w); }
    { u32x4 w = {cvtpk(k10[0], k10[1]), cvtpk(k10[2], k10[3]), cvtpk(k11[0], k11[1]), cvtpk(k11[2], k11[3])}; st.k1 = __builtin_bit_cast(bx8, w); }
    { u32x4 w = {cvtpk(v00[0], v00[1]), cvtpk(v00[2], v00[3]), cvtpk(v01[0], v01[1]), cvtpk(v01[2], v01[3])}; st.v0 = __builtin_bit_cast(bx8, w); }
    { u32x4 w = {cvtpk(v10[0], v10[1]), cvtpk(v10[2], v10[3]), cvtpk(v11[0], v11[1]), cvtpk(v11[2], v11[3])}; st.v1 = __builtin_bit_cast(bx8, w); }
    stage_write(st, lds, 0, I);
}
}
constexpr int CV_NB_IN = (NSRC + 63) / 64, CV_IN = 64 * CV_NB_IN, CV_OUT = 64 * 64, CV_UP = 64 * 256, CV_DN = 256 * 64, CV_L = CV_IN + CV_OUT + CV_UP + CV_DN;
#ifndef CVQ_A
#define CVQ_A 7000
#endif
#ifndef CVQ_P0
#define CVQ_P0 2
#endif
#ifndef CVQ_P1
#define CVQ_P1 3
#endif
#ifndef CVQ_A0
#define CVQ_A0 10500
#endif
constexpr int CVQ_LO[4] = {CV_IN, CV_IN + CV_OUT + CVQ_A0, CV_L + CV_IN, CV_L + CV_IN + CV_OUT + CVQ_A};
constexpr int CVQ_HI[4] = {CV_IN + CV_OUT + CVQ_A0, CV_L + CV_IN, CV_L + CV_IN + CV_OUT + CVQ_A, 2 * CV_L};
__device__ __forceinline__ bool cv_deferred(int it) { return DEFER_CONV && ((it >= CVQ_LO[0] && it < CVQ_HI[1]) || (it >= CVQ_LO[2] && it < CVQ_HI[3])); }
__device__ __forceinline__ void conv_item(const Frame& F, int it, int lane) {
    const int L = it / CV_L; int r = it - L * CV_L;
    if (r < CV_IN) { transpose_item<true>(PIN(1) + (size_t)L * DM * NSRC, DM, NSRC, PWS(bf16, WS_WIN) + (size_t)L * NP * DM, r / CV_NB_IN, r % CV_NB_IN, lane, nullptr, nullptr, PIN(3) + (size_t)L * DM); return; } r -= CV_IN;
    if (r < CV_OUT) { transpose_item<false>(PIN(2) + (size_t)L * DM * DM, DM, DM, PWS(bf16, WS_WOUT) + (size_t)L * DM * DM, r / 64, r % 64, lane); return; } r -= CV_OUT;
    if (r < CV_UP) { transpose_item<false>(PIN(5) + (size_t)L * DM * DFF, DM, DFF, PWS(bf16, WS_WUP) + (size_t)L * DFF * DM, r / 256, r % 256, lane, nullptr, nullptr, PIN(4) + (size_t)L * DM); return; } r -= CV_UP;
    transpose_item<false>(PIN(6) + (size_t)L * DFF * DM, DFF, DM, PWS(bf16, WS_WDN) + (size_t)L * DM * DFF, r / 64, r % 64, lane);
}
__device__ __forceinline__ TrItem conv_make(const Frame& F, int it, int lane) {
    const int L = it / CV_L; int r = it - L * CV_L;
    if (r < CV_IN) return tr_make(PIN(1) + (size_t)L * DM * NSRC, DM, NSRC, PWS(bf16, WS_WIN) + (size_t)L * NP * DM, r / CV_NB_IN, r % CV_NB_IN, lane, PIN(3) + (size_t)L * DM, true); r -= CV_IN;
    if (r < CV_OUT) return tr_make(PIN(2) + (size_t)L * DM * DM, DM, DM, PWS(bf16, WS_WOUT) + (size_t)L * DM * DM, r / 64, r % 64, lane, nullptr, false); r -= CV_OUT;
    if (r < CV_UP) return tr_make(PIN(5) + (size_t)L * DM * DFF, DM, DFF, PWS(bf16, WS_WUP) + (size_t)L * DFF * DM, r / 256, r % 256, lane, PIN(4) + (size_t)L * DM, false); r -= CV_UP;
    return tr_make(PIN(6) + (size_t)L * DFF * DM, DFF, DM, PWS(bf16, WS_WDN) + (size_t)L * DM * DFF, r / 64, r % 64, lane, nullptr, false);
}
template <int CH> __device__ __forceinline__ bool conv_chunk(const Frame& F, const Ctx& C, int q) {
    const int lo_ = q == 0 ? CVQ_LO[0] : q == 1 ? CVQ_LO[1] : q == 2 ? CVQ_LO[2] : CVQ_LO[3], hi_ = q == 0 ? CVQ_HI[0] : q == 1 ? CVQ_HI[1] : q == 2 ? CVQ_HI[2] : CVQ_HI[3];
    if (C.wave == 0 && fresh_lane() == 0) F.MISC[52] = __hip_atomic_fetch_add(PWS(unsigned, WS_CTL) + 251000 + 64 * q, 1u, __ATOMIC_RELAXED, __HIP_MEMORY_SCOPE_AGENT);
    __syncthreads(); const int c = (int)__builtin_amdgcn_readfirstlane((int)F.MISC[52]); __syncthreads();
    const long base = (long)lo_ + (long)c * (8 * CH); if (base >= hi_) return false;
    const int lane = fresh_lane();
    if constexpr (CH == 4) {
        const long it0 = base + C.wave * CH; const int nit = (hi_ - it0) < CH ? (int)(hi_ - it0) : CH;
        if (nit == CH) { f32x4 va[16], vb[16];
            TrItem ta = conv_make(F, (int)it0, lane); tr_load(va, ta);
            TrItem tb = conv_make(F, (int)it0 + 1, lane); tr_load(vb, tb);
            tr_store(va, ta); ta = conv_make(F, (int)it0 + 2, lane); tr_load(va, ta);
            tr_store(vb, tb); tb = conv_make(F, (int)it0 + 3, lane); tr_load(vb, tb);
            tr_store(va, ta); tr_store(vb, tb);
        } else {
#pragma unroll 1
            for (int j = 0; j < nit; ++j) conv_item(F, (int)(it0 + j), lane); }
    } else {
#pragma unroll 1
    for (int j = 0; j < CH; ++j) { const long it = base + C.wave * CH + j; if (it < hi_) conv_item(F, (int)it, lane); }
    }
    return true;
}
__device__ __forceinline__ void p0_prologue(const Frame& F, const Ctx& C) {
    const int lane = C.lane, tid = C.tid;
    {
        bf16* Win_t = PWS(bf16, WS_WIN);
        for (int rep_ = 0; rep_ < NREP(0); ++rep_)
        for (int it = C.gw; it < DEPTH * CV_L; it += C.ngw) { if (!cv_deferred(it)) conv_item(F, it, lane); }
        for (int it = C.gw; it < DEPTH * (NP - NSRC); it += C.ngw) { const int L = it / (NP - NSRC), r = NSRC + it % (NP - NSRC);
            v4u* p = (v4u*)(Win_t + (size_t)L * NP * DM + (size_t)r * DM); const v4u z = {0u, 0u, 0u, 0u};
#pragma unroll
            for (int j = 0; j < 8; ++j) p[lane + 64 * j] = z; }
    }
    for (int rep9_ = 0; rep9_ < NREP(9); ++rep9_) {
    {
        bf16* W1t = PWS(bf16, WS_W1T); float* PEP = PWS(float, WS_PEP);
        for (int it = C.gw; it < DEPTH * 2 * 512; it += C.ngw) { const int lt = it >> 9, r = it & 511; const float* w1 = PIN((lt & 1) ? 11 : 9) + (size_t)(lt >> 1) * 8192 * 256;
            transpose_item<false, true>(w1, 8192, 256, W1t + (size_t)lt * 256 * 8192, r >> 2, r & 3, lane, PIN((lt & 1) ? 8 : 7) + (size_t)(lt >> 1) * 8192, PEP + (size_t)lt * 2 * 256); }
        float* KC = PWS(float, WS_KC); for (int e = C.gw * 64 + lane; e < 2 * 2 * 256 * 128; e += C.ngw * 64) KC[e] = 0.f;
    }
    {
        float* cosT = PWS(float, WS_COS); float* sinT = PWS(float, WS_SIN);
        for (int e = C.bid * (NWAVES * 64) + tid; e < SEQ * 64; e += C.G * NWAVES * 64) { const int t = e >> 6, i = e & 63;
            double p = 1.0; for (int k = 0; k < i; ++k) p *= 1.1547819846894583;
            const float pf = (float)p, inv = (float)(1.0 / (double)pf), ang = __fmul_rn((float)t, inv);
            double s, c; sincos_red((double)ang, s, c); cosT[e] = (float)c; sinT[e] = (float)s; }
    }
    raw_phase(C, PIN(0), PWS(bf16, WS_H), PWS(float, WS_SS));
    }
}

__device__ __forceinline__ float dot128_bf(const LAS float* q, const bf16* krow) {
    float s0 = 0.f, s1 = 0.f;
#pragma unroll 1
    for (int c4 = 0; c4 < 16; c4 += 4) {
#pragma unroll
        for (int cc = 0; cc < 4; ++cc) { const int c = c4 + cc; const v4u kk = *(const v4u*)(krow + 8 * c); const f32x4 qa = *(const LAS f32x4*)(q + 8 * c), qb = *(const LAS f32x4*)(q + 8 * c + 4);
            s0 = fmaf(qa.x, blo(kk.x), s0); s1 = fmaf(qa.y, bhi(kk.x), s1); s0 = fmaf(qa.z, blo(kk.y), s0); s1 = fmaf(qa.w, bhi(kk.y), s1);
            s0 = fmaf(qb.x, blo(kk.z), s0); s1 = fmaf(qb.y, bhi(kk.z), s1); s0 = fmaf(qb.z, blo(kk.w), s0); s1 = fmaf(qb.w, bhi(kk.w), s1); } }
    return s0 + s1;
}
__device__ __forceinline__ float dot128_f(const LAS float* q, const float* krow) {
    float s0 = 0.f, s1 = 0.f;
#pragma unroll 1
    for (int c8 = 0; c8 < 32; c8 += 8) {
#pragma unroll
        for (int cc = 0; cc < 8; ++cc) { const int c = c8 + cc; const f32x4 kk = *(const f32x4*)(krow + 4 * c), qa = *(const LAS f32x4*)(q + 4 * c);
            s0 = fmaf(qa.x, kk.x, s0); s1 = fmaf(qa.y, kk.y, s1); s0 = fmaf(qa.z, kk.z, s0); s1 = fmaf(qa.w, kk.w, s1); } }
    return s0 + s1;
}
__device__ __forceinline__ void load_q(LAS float* qs, const bf16* qrow, int lane) {
    const unsigned w = *(const unsigned*)(qrow + 2 * lane); qs[2 * lane] = blo(w); qs[2 * lane + 1] = bhi(w); LDS_WAIT(); asm volatile("" ::: "memory");
}
struct SmState { float m, l, o0, o1; };
__device__ __forceinline__ void sm_chunk(SmState& S, float s, const bf16* vrow0, long vstep, int nk, LAS float* ps, int lane) {
    const float mx = wave_max(s), mn = fmaxf(S.m, mx), alpha = ex2(S.m - mn), p = ex2(s - mn);
    S.l = S.l * alpha + wave_sum(p); S.o0 *= alpha; S.o1 *= alpha; S.m = mn;
    asm volatile("" ::: "memory"); ps[lane] = p; LDS_WAIT(); asm volatile("" ::: "memory");
#pragma unroll 4
    for (int k = 0; k < nk; ++k) { const float pk = ps[k]; const unsigned w = *(const unsigned*)(vrow0 + (long)k * vstep + 2 * lane); S.o0 = fmaf(pk, blo(w), S.o0); S.o1 = fmaf(pk, bhi(w), S.o1); }
    LDS_WAIT(); asm volatile("" ::: "memory");
}
__device__ __forceinline__ void compress_item(const Frame& F, const Ctx& C, int L, int item) {
    const int lane = C.lane, tid = C.tid;
    const int ten = item >> 5, rg = item & 31;
    const float* w1 = PIN(ten ? 11 : 9) + (size_t)L * 8192 * 256; const float* w2 = PIN(ten ? 12 : 10) + (size_t)L * 256 * 128;
    const float* pe = PIN(ten ? 8 : 7) + (size_t)L * 8192; const int ccol = ten ? C_VC : C_KC;
    const bf16* PROJ = PWS(bf16, WS_PROJ); float* KC = PWS(float, WS_KC) + (PROBE_SEC == 4 ? 65536 : 0);
    float acc[8][4];
#pragma unroll
    for (int i = 0; i < 8; ++i)
#pragma unroll
        for (int jb = 0; jb < 4; ++jb) acc[i][jb] = 0.f;
    for (int k0 = C.wave * 1024; k0 < C.wave * 1024 + 1024; k0 += 64) {
        const int tok = k0 >> 7, d = (k0 & 127) + lane; float a[8];
#pragma unroll
        for (int i = 0; i < 8; ++i) { const int r = rg * 8 + i, g = r & 1, n = (r >> 1) & 63, b = r >> 7;
            a[i] = bf2f(PROJ[(size_t)(b * SEQ + n * 64 + tok) * NP + ccol + g * 128 + d]) + pe[k0 + lane]; }
#pragma unroll 4
        for (int kk = 0; kk < 64; ++kk) { const float* wr = w1 + (size_t)(k0 + kk) * 256 + lane; float wv[4];
#pragma unroll
            for (int jb = 0; jb < 4; ++jb) wv[jb] = wr[64 * jb];
#pragma unroll
            for (int i = 0; i < 8; ++i) { const float ai = __shfl(a[i], kk);
#pragma unroll
                for (int jb = 0; jb < 4; ++jb) acc[i][jb] = fmaf(ai, wv[jb], acc[i][jb]); } }
    }
    LAS float* red = (LAS float*)(C.lds + RING_OFF);
#pragma unroll
    for (int i = 0; i < 8; ++i)
#pragma unroll
        for (int jb = 0; jb < 4; ++jb) red[(C.wave * 8 + i) * 256 + jb * 64 + lane] = acc[i][jb];
    __syncthreads();
    LAS float* hid = red + 8 * 8 * 256;
    for (int e = tid; e < 8 * 256; e += NWAVES * 64) { float h = 0.f;
#pragma unroll
        for (int w = 0; w < 8; ++w) h += red[w * 2048 + e];
        hid[e] = h / (1.0f + __expf(-h)); }
    __syncthreads();
    { const int i = C.wave; float o0 = 0.f, o1 = 0.f;
        for (int j = 0; j < 256; ++j) { const float hv = hid[i * 256 + j]; o0 = fmaf(hv, w2[j * 128 + lane], o0); o1 = fmaf(hv, w2[j * 128 + 64 + lane], o1); }
#if PROBE_SEC >= 1 && PROBE_SEC <= 3
        o0 = __uint_as_float(f2bf(o0) << 16); o1 = __uint_as_float(f2bf(o1) << 16);
#endif
        float* dst = KC + ((size_t)ten * 256 + rg * 8 + i) * 128; dst[lane] = o0; dst[64 + lane] = o1;
        bf16* dsb = PWS(bf16, WS_KCB) + ((size_t)ten * 256 + rg * 8 + i) * 128; dsb[lane] = (bf16)f2bf(o0); dsb[64 + lane] = (bf16)f2bf(o1); }
    __syncthreads();
}
__device__ __forceinline__ void dil_item(const bf16* PROJ, bf16* OCAT, int it, LAS float* qs, LAS float* ps, int lane) {
    const int i = it & 3, t = (it >> 2) & (SEQ - 1), b = it >> 14; const size_t row = (size_t)b * SEQ + t;
    LAS float* og = qs + 256;
#pragma unroll 1
    for (int gi = 0; gi < 3; ++gi) { const int head = gi * 4 + i, dd = 1 << (2 * gi);
        load_q(qs, PROJ + row * NP + C_DQ + head * 128, lane);
        SmState S; S.m = -1e30f; S.l = 0.f; S.o0 = 0.f; S.o1 = 0.f;
#pragma unroll 1
        for (int c = 0; c < 3; ++c) { const int k = c * 64 + lane, key = t - k * dd; const bool valid = (k <= 128) && (key >= 0);
            float s = dot128_bf(qs, PROJ + ((size_t)b * SEQ + (valid ? key : t)) * NP + C_DK + head * 128); if (!valid) s = -__builtin_inff();
            int nk = 129 - c * 64; if (nk > 64) nk = 64; const int kmax = t / dd - c * 64 + 1; if (nk > kmax) nk = kmax;
            if (nk > 0) sm_chunk(S, s, PROJ + ((size_t)b * SEQ + (t - c * 64 * dd)) * NP + C_DV + head * 128, -(long)dd * NP, nk, ps, lane); }
        const float rl = 1.0f / S.l; og[gi * 128 + 2 * lane] = S.o0 * rl; og[gi * 128 + 2 * lane + 1] = S.o1 * rl; if (lane == 0) og[384 + gi] = S.m + lg2(S.l); }
    LDS_WAIT(); asm volatile("" ::: "memory");
    const float l0 = og[384], l1 = og[385], l2 = og[386], mx = fmaxf(l0, fmaxf(l1, l2));
    const float w0 = ex2(l0 - mx), w1 = ex2(l1 - mx), w2 = ex2(l2 - mx), rden = 1.0f / (w0 + w1 + w2);
#pragma unroll 1
    for (int gi = 0; gi < 3; ++gi) { const float al = (gi == 0 ? w0 : gi == 1 ? w1 : w2) * rden;
        *(unsigned*)(OCAT + row * DM + 1536 + (gi * 4 + i) * 128 + 2 * lane) = pk2(og[gi * 128 + 2 * lane] * al, og[gi * 128 + 2 * lane + 1] * al); }
    LDS_WAIT(); asm volatile("" ::: "memory");
}
__device__ __forceinline__ void sb_item(const bf16* PROJ, bf16* OCAT, int it, LAS float* qs, LAS float* ps, int lane) {
    const int h = it & 7, t = (it >> 3) & (SEQ - 1), b = it >> 15; const size_t row = (size_t)b * SEQ + t;
    load_q(qs, PROJ + row * NP + C_SQ + h * 128, lane);
    float R = 0.f, o0 = 0.f, o1 = 0.f;
#pragma unroll 1
    for (int c = 0; c * 64 < t; ++c) { const int key = t - 1 - (c * 64 + lane); const bool valid = key >= 0;
        const float z = dot128_bf(qs, PROJ + ((size_t)b * SEQ + (valid ? key : 0)) * NP + C_SK + h * 128);
        const float e = ex2(-fabsf(z)), lg = lg2(1.0f + e), lb = fminf(z, 0.f) - lg, l1m = valid ? (lb - z) : 0.f;
        float incl = l1m;
#pragma unroll
        for (int o = 1; o < 64; o <<= 1) { const float u = __shfl_up(incl, o); if (lane >= o) incl += u; }
        const float a = valid ? ex2(lb + R + (incl - l1m)) : 0.f;
        R += __shfl(incl, 63);
        asm volatile("" ::: "memory"); ps[lane] = a; LDS_WAIT(); asm volatile("" ::: "memory");
        int nk = t - c * 64; if (nk > 64) nk = 64;
        const bf16* v0 = PROJ + ((size_t)b * SEQ + (t - 1 - c * 64)) * NP + C_SV + h * 128 + 2 * lane;
#pragma unroll 4
        for (int k = 0; k < nk; ++k) { const float pk = ps[k]; const unsigned w = *(const unsigned*)(v0 - (long)k * NP); o0 = fmaf(pk, blo(w), o0); o1 = fmaf(pk, bhi(w), o1); }
        LDS_WAIT(); asm volatile("" ::: "memory"); }
    *(unsigned*)(OCAT + row * DM + 3072 + h * 128 + 2 * lane) = pk2(o0, o1);
}
__device__ __forceinline__ void cmp_item(const bf16* PROJ, const float* KC, float* OCMP, unsigned long long* SEL, int it, LAS float* qs, LAS float* ps, int lane) {
    const int t = it & (SEQ - 1), g = (it >> 12) & 1, b = it >> 13; const size_t row = (size_t)b * SEQ + t;
    const int nvalid = (t + 1) >> 6, cur = t >> 6; const bool valid = lane < nvalid; float imp = 0.f;
#pragma unroll 1
    for (int r = 0; r < 6; ++r) { const int h = g * 6 + r;
        load_q(qs, PROJ + row * NP + C_NQ + h * 128, lane);
        const float s = dot128_f(qs, KC + ((size_t)(b * 64 + lane) * 2 + g) * 128);
        float p = 0.f;
        if (nvalid > 0) { const float m = wave_max(valid ? s : -__builtin_inff()), e = valid ? ex2(s - m) : 0.f, l = wave_sum(e); p = e / l; }
        imp += p;
        asm volatile("" ::: "memory"); ps[lane] = p; LDS_WAIT(); asm volatile("" ::: "memory");
        float o0 = 0.f, o1 = 0.f;
#pragma unroll 4
        for (int n = 0; n < nvalid; ++n) { const float pn = ps[n]; const float2 v = *(const float2*)(KC + ((size_t)256 + (b * 64 + n) * 2 + g) * 128 + 2 * lane); o0 = fmaf(pn, v.x, o0); o1 = fmaf(pn, v.y, o1); }
        LDS_WAIT(); asm volatile("" ::: "memory");
        *(float2*)(OCMP + row * 1536 + h * 128 + 2 * lane) = make_float2(o0, o1); }
    const bool forced = (lane == 0) || (lane == cur) || (lane == cur - 1), started = lane <= cur;
    const float score = forced ? 7.0f : (started ? imp : -1.0f);
    int rank = 0;
#pragma unroll 8
    for (int i = 0; i < 64; ++i) { const float vi = __shfl(score, i); rank += ((vi > score) || (vi == score && i < lane)) ? 1 : 0; }
    const unsigned long long mask = __ballot(rank < 16);
    if (lane == 0) SEL[(size_t)(b * 2 + g) * SEQ + t] = mask;
}
__device__ __forceinline__ void nsa_item(const bf16* PROJ, const bf16* KVC, const float* OCMP, const unsigned long long* SEL, bf16* OCAT, int it, LAS float* qs, LAS float* ps, int lane) {
    const int h = it % 12, bt = it / 12, t = bt & (SEQ - 1), b = bt >> 12, g = h / 6; const size_t row = (size_t)b * SEQ + t;
    const bf16* prow = PROJ + row * NP;
    load_q(qs, prow + C_NQ + h * 128, lane);
    const unsigned long long mask = SEL[(size_t)(b * 2 + g) * SEQ + t]; const int cur = t >> 6;
    SmState S; S.m = -1e30f; S.l = 0.f; S.o0 = 0.f; S.o1 = 0.f;
#pragma unroll 1
    for (int j = 0; j <= cur; ++j) { if (!((mask >> j) & 1ull)) continue;
        const int key = j * 64 + lane; float s = dot128_bf(qs, KVC + ((size_t)(0 + g) * MTOK + (size_t)b * SEQ + key) * 128); if (key > t) s = -__builtin_inff();
        int nk = t - j * 64 + 1; if (nk > 64) nk = 64;
        sm_chunk(S, s, KVC + ((size_t)(4 + g) * MTOK + (size_t)b * SEQ + j * 64) * 128, 128L, nk, ps, lane); }
    const float rs = 1.0f / S.l, os0 = S.o0 * rs, os1 = S.o1 * rs;
    S.m = -1e30f; S.l = 0.f; S.o0 = 0.f; S.o1 = 0.f;
    const int lowk = t - 511 > 0 ? t - 511 : 0;
#pragma unroll 1
    for (int kb = lowk & ~63; kb <= t; kb += 64) { const int key = kb + lane; const bool valid = key >= lowk && key <= t;
        float s = dot128_bf(qs, KVC + ((size_t)(2 + g) * MTOK + (size_t)b * SEQ + key) * 128); if (!valid) s = -__builtin_inff();
        int nk = t - kb + 1; if (nk > 64) nk = 64;
        sm_chunk(S, s, KVC + ((size_t)(6 + g) * MTOK + (size_t)b * SEQ + kb) * 128, 128L, nk, ps, lane); }
    const float rw = 1.0f / S.l, ow0 = S.o0 * rw, ow1 = S.o1 * rw;
    const float g0 = 1.0f / (1.0f + __expf(-bf2f(prow[C_GT + h * 3 + 0]))), g1 = 1.0f / (1.0f + __expf(-bf2f(prow[C_GT + h * 3 + 1]))), g2 = 1.0f / (1.0f + __expf(-bf2f(prow[C_GT + h * 3 + 2])));
    const float2 oc = *(const float2*)(OCMP + row * 1536 + h * 128 + 2 * lane);
    *(unsigned*)(OCAT + row * DM + h * 128 + 2 * lane) = pk2(PBR(1) * g0 * oc.x + PBR(2) * g1 * os0 + PBR(3) * g2 * ow0, PBR(1) * g0 * oc.y + PBR(2) * g1 * os1 + PBR(3) * g2 * ow1);
}

#define PH_LO() (__builtin_amdgcn_readfirstlane((int)F.MISC[53]))
#define PH_HI() (__builtin_amdgcn_readfirstlane((int)F.MISC[54]))
#define IN(k) (PH_LO() <= (k) && (k) < PH_HI())
#define SEAM(k) do { if (IN(k) && IN((k) + 1)) { TSTAMP(); for (int rs_ = 0; rs_ < NREP(12); ++rs_) { XcdBarrier b_; b_.bar = PWS(unsigned, WS_CTL) + CW_BAR + PH_LO() * XCD_BAR_WORDS; b_.x = xb_xcc_id(); b_.st = F.MISC + 8; xcd_barrier(b_); } TSTAMP(); } } while (0)
#define QS ((LAS float*)(C.lds + RING_OFF + C.wave * 4096))
#define PS (QS + 128)
#if PROBE_SEC
__device__ __forceinline__ void probe_phases(const Frame& F) {

    SEAM(1);
#if PROBE_SEC == 5
    if (IN(2)) { CTX();
        const bf16* PROJ = PWS(bf16, WS_PROJ); const bf16* KVC = PWS(bf16, WS_KVC); float* out = (float*)rd_ptr(F, PT_OUT);
        for (size_t e = (size_t)C.gw * 64 + C.lane; e < (size_t)MTOK * DM; e += (size_t)C.ngw * 64) { const int col = (int)(e & (DM - 1)); const size_t row = e >> 12; float v = 0.f;
            if (col < 1024) { const int hd = col >> 7, d = col & 127, kind = hd >> 1, g = hd & 1; const int cb = kind == 0 ? C_KS : kind == 1 ? C_KW : kind == 2 ? C_VS : C_VW;
                v = (float)PROBE_C * (bf2f(KVC[((size_t)hd * MTOK + row) * 128 + d]) - bf2f(PROJ[row * NP + cb + g * 128 + d])); }
            out[e] = v; } }
    return;
#endif
#if PROBE_SEC == 4
    if (IN(2)) { CTX();
        const bf16* PROJ = PWS(bf16, WS_PROJ); const fa::Ids I = fa::make_ids(C.wave, C.lane);
        const bf16* W1t = PWS(bf16, WS_W1T); const float* PEP = PWS(float, WS_PEP); float* KC = PWS(float, WS_KC);
        for (int u = C.bid; u < 128; u += C.G) fa::compress_unit(PROJ, W1t, PEP, PIN((u >> 6) ? 12 : 10), KC, u, C.lds + RING_OFF, I);
        __syncthreads();
        for (int it = C.bid; it < 64; it += C.G) compress_item(F, C, 0, it);
        SEAM(2); }
    if (IN(3)) { CTX();
        const float* KC = PWS(float, WS_KC); float* out = (float*)rd_ptr(F, PT_OUT);
        for (size_t e = (size_t)C.gw * 64 + C.lane; e < (size_t)MTOK * DM; e += (size_t)C.ngw * 64) out[e] = e < 65536 ? (float)PROBE_C * (KC[e] - KC[e + 65536]) : 0.f; }
    return;
#endif
    if (IN(2)) { CTX();
        for (int it = C.bid; it < 64; it += C.G) compress_item(F, C, 0, it);
        const int lane = C.lane; const bf16* PROJ = PWS(bf16, WS_PROJ); bf16* OCAT = PWS(bf16, WS_OCAT); bf16* OCATB = PWS(bf16, WS_U);
        { __syncthreads(); float* LSE = PWS(float, WS_LSE);
          for (int u = C.bid; u < BATCH * 12 * 16; u += C.G) { const int head = u % 12, rest = u / 12, bb = rest >> 4, blk = rest & 15, gi = head >> 2, dd = 1 << (2 * gi);
              const int nblk = 16 >> (2 * gi), res = blk / nblk, m0 = (blk % nblk) * 256;
              const fa::Ids I = fa::make_ids_op(C.wave, fresh_lane()); fa::dil_unit(PROJ, OCAT, LSE, bb, head, dd, res, m0, C.lds + RING_OFF, I); }
          for (int u = C.bid; u < BATCH * 8 * 16; u += C.G) { const fa::Ids I = fa::make_ids_op(C.wave, fresh_lane()); fa::sb_unit(PROJ, OCAT, u >> 7, (u >> 4) & 7, (u & 15) * 256, C.lds + RING_OFF, I); } }
        __syncthreads();
        for (int it = C.gw; it < BATCH * SEQ * 4; it += C.ngw) dil_item(PROJ, OCATB, it, QS, PS, lane);
        for (int it = C.gw; it < BATCH * SEQ * 8; it += C.ngw) sb_item(PROJ, OCATB, it, QS, PS, lane);
        SEAM(2); }
    if (IN(3)) { CTX();
        const int lane = C.lane; const bf16* PROJ = PWS(bf16, WS_PROJ); const float* KC = PWS(float, WS_KC); float* OCMP = PWS(float, WS_OCMP); unsigned long long* SEL = PWS(unsigned long long, WS_SEL);
        for (int it = C.gw; it < BATCH * 2 * SEQ; it += C.ngw) cmp_item(PROJ, KC, OCMP, SEL, it, QS, PS, lane);
        { __syncthreads();
          for (int u = C.bid; u < 64; u += C.G) { const fa::Ids I = fa::make_ids_op(C.wave, fresh_lane()); fa::cmp_unit(PROJ, KC, PWS(float, WS_X), PWS(unsigned long long, WS_SEL) + 32768, (u >> 1) & 1, u & 1, (15 - (u >> 2)) * 256, C.lds + RING_OFF, I); } }
        SEAM(3); }
    if (IN(4)) { CTX();
        const int lane = C.lane; const bf16* PROJ = PWS(bf16, WS_PROJ); const float* OCMP = PWS(float, WS_OCMP); const unsigned long long* SEL = PWS(unsigned long long, WS_SEL); bf16* OCAT = PWS(bf16, WS_OCAT); bf16* OCATB = PWS(bf16, WS_U);
        { const float* LSE = PWS(float, WS_LSE); for (int it = C.gw; it < MTOK * 4; it += C.ngw) fa::dil_fixup(OCAT, LSE, it, lane); }
        { __syncthreads(); float* ACC = PWS(float, WS_X);
          for (int k = 0; ; ++k) { const int u = k * C.G + ((k & 1) ? C.G - 1 - C.bid : C.bid); if (u >= BATCH * 12 * 16) break;
              const fa::Ids I = fa::make_ids_op(C.wave, fresh_lane()); const int blk = 15 - u / 24, bh = u % 24; const bf16* PROJ_ = PROJ; const bf16* KVC_ = PWS(bf16, WS_KVC); const unsigned long long* SEL_ = PWS(unsigned long long, WS_SEL) + 32768; float* ACC_ = ACC; bf16* OCAT_ = OCAT; asm volatile("" : "+s"(PROJ_), "+s"(SEL_), "+s"(ACC_), "+s"(OCAT_), "+s"(KVC_));
              fa::nsa_unit(PROJ_, KVC_, SEL_, ACC_, OCAT_, bh / 12, bh % 12, blk * 256, C.lds + RING_OFF, I); } }
        __syncthreads();
        for (int it = C.gw; it < BATCH * SEQ * 12; it += C.ngw) nsa_item(PROJ, PWS(bf16, WS_KVC), OCMP, SEL, OCATB, it, QS, PS, lane);
        SEAM(4); }
    if (IN(5)) { CTX();
        const bf16* OCAT = PWS(bf16, WS_OCAT); const bf16* OCATB = PWS(bf16, WS_U); float* out = (float*)rd_ptr(F, PT_OUT);
        constexpr int c_lo = PROBE_SEC == 1 ? 0 : PROBE_SEC == 2 ? 1536 : 3072, c_hi = PROBE_SEC == 1 ? 1536 : PROBE_SEC == 2 ? 3072 : 4096;
        for (size_t e = (size_t)C.gw * 64 + C.lane; e < (size_t)MTOK * DM; e += (size_t)C.ngw * 64) { const int col = (int)(e & (DM - 1));
            out[e] = (col >= c_lo && col < c_hi) ? (float)PROBE_C * (bf2f(OCAT[e]) - bf2f(OCATB[e])) : 0.f; } }
}
#endif
template <int L> __device__ __forceinline__ void layer_phases(const Frame& F) {
    constexpr int pb = 1 + 9 * L;
        if (IN(pb + 0)) {
            CTX();
            pg8::Gemm g{PWS(bf16, WS_H), PWS(bf16, WS_WIN) + (size_t)L * NP * DM, MTOK, NP, DM};
            pg8::EpiProj E{PWS(bf16, WS_PROJ), NP, PWS(float, WS_COS), PWS(float, WS_SIN), SEQ, PWS(float, WS_SS) + (size_t)(2 * L) * 2 * MTOK, PWS(bf16, WS_KVC), MTOK, 0};
#if SPLIT_INPROJ
            pg8::MapOrder<1> S; S.init(MTOK, NP - 768, C.G, C.bid); pg8::gemm_phase<pg8::EpiProj, pg8::MapOrder<1>, true, true>(C.lds + RING_OFF, g, S, E, C.wave);
#else
            pg8::StaticOrder S; S.init(MTOK, NP, C.G, C.bid); pg8::gemm_phase<pg8::EpiProj, pg8::StaticOrder, true, true>(C.lds + RING_OFF, g, S, E, C.wave);
#endif
            SEAM(pb + 0);
        }
        if (IN(pb + 1)) {
            CTX();
            const int ngemm = (SPLIT_INPROJ && C.G > 96) ? 96 : 0;
#if SPLIT_INPROJ
            {   pg8::Gemm g{PWS(bf16, WS_H), PWS(bf16, WS_WIN) + (size_t)L * NP * DM, MTOK, NP, DM}; pg8::MapOrder<2> S; S.init(MTOK, 768, ngemm ? ngemm : C.G, C.bid);
                pg8::EpiProj E{PWS(bf16, WS_PROJ), NP, PWS(float, WS_COS), PWS(float, WS_SIN), SEQ, PWS(float, WS_SS) + (size_t)(2 * L) * 2 * MTOK, PWS(bf16, WS_KVC), MTOK, 0};
                pg8::gemm_phase<pg8::EpiProj, pg8::MapOrder<2>, true, true>(C.lds + RING_OFF, g, S, E, C.wave); }
#endif
            {
                const bf16* PROJ = PWS(bf16, WS_PROJ); bf16* OCAT = PWS(bf16, WS_OCAT); float* LSE = PWS(float, WS_LSE);
                const bf16* W1t = PWS(bf16, WS_W1T) + (size_t)L * 2 * 256 * 8192; const float* PEP = PWS(float, WS_PEP) + (size_t)L * 2 * 2 * 256; float* KC = PWS(float, WS_KC);
                int cleft = DEFER_CONV; asm volatile("" : "+s"(cleft));
                for (;;) {
                    if (C.wave == 0 && fresh_lane() == 0) F.MISC[52] = __hip_atomic_fetch_add(PWS(unsigned, WS_CTL) + 250000 + 64 * L, 1u, __ATOMIC_RELAXED, __HIP_MEMORY_SCOPE_AGENT);
                    __syncthreads(); const int v = (int)__builtin_amdgcn_readfirstlane((int)F.MISC[52]); __syncthreads();
                    if (v >= 128 + 256 + 64 + 384) break;
                    const fa::Ids I = fa::make_ids_op(C.wave, fresh_lane());
                    unsigned* done = PWS(unsigned, WS_CTL) + 252000 + 64 * L;
                    if (v < 128) fa::compress_unit(PROJ, W1t, PEP, PIN((v >> 6) ? 12 : 10) + (size_t)L * 256 * 128, KC, v, C.lds + RING_OFF, I, done);
                    else if (v < 384) { const int u = v - 128; fa::sb_unit(PROJ, OCAT, u >> 7, (u >> 4) & 7, (u & 15) * 256, C.lds + RING_OFF, I); }
                    else if (v < 448) { const int u = v - 384;
                        if (C.wave == 0) { unsigned sp = 0u;
                            while ((unsigned)__builtin_amdgcn_readfirstlane((int)__hip_atomic_load(done, __ATOMIC_RELAXED, __HIP_MEMORY_SCOPE_AGENT)) < 128u) { __builtin_amdgcn_s_sleep(4); if (++sp > (1u << 22)) break; }
                            __builtin_amdgcn_fence(__ATOMIC_ACQUIRE, "agent"); asm volatile("s_waitcnt vmcnt(0)" ::: "memory"); }
                        __syncthreads();
                        fa::cmp_unit(PROJ, KC, PWS(float, WS_OCMP), PWS(unsigned long long, WS_SEL), (u >> 1) & 1, u & 1, (15 - (u >> 2)) * 256, C.lds + RING_OFF, I); }
                    else { const int u = v - 448, head = u % 12, rest = u / 12, bb = rest >> 4, blk = rest & 15, gi = head >> 2, dd = 1 << (2 * gi);
                        const int nblk = 16 >> (2 * gi), res = blk / nblk, m0 = (blk % nblk) * 256;
                        fa::dil_unit(PROJ, OCAT, LSE, bb, head, dd, res, m0, C.lds + RING_OFF, I); }
                    if (DEFER_CONV) {
#pragma unroll 1
                        for (int p_ = 0; p_ < CVQ_P0 && cleft; ++p_) cleft = conv_chunk<1>(F, C, 2 * L) ? 1 : 0; } }
                if (DEFER_CONV) {
#pragma unroll 1
                    while (cleft) cleft = conv_chunk<1>(F, C, 2 * L) ? 1 : 0; } }
            SEAM(pb + 1);
        }
#if !USE_FA_NSA
        if (IN(pb + 2)) {
            CTX();
            const int lane = C.lane; const bf16* PROJ = PWS(bf16, WS_PROJ); const float* KC = PWS(float, WS_KC); float* OCMP = PWS(float, WS_OCMP); unsigned long long* SEL = PWS(unsigned long long, WS_SEL);
#if !USE_FA_NSA
            for (int it = C.gw; it < BATCH * 2 * SEQ; it += C.ngw) cmp_item(PROJ, KC, OCMP, SEL, it, QS, PS, lane);
#endif
            SEAM(pb + 2);
        }
#endif
        if (IN(pb + 3)) {
            CTX();
            const int lane = C.lane; const bf16* PROJ = PWS(bf16, WS_PROJ); const float* OCMP = PWS(float, WS_OCMP); const unsigned long long* SEL = PWS(unsigned long long, WS_SEL); bf16* OCAT = PWS(bf16, WS_OCAT);
#if USE_FA_DIL
            { const float* LSE = PWS(float, WS_LSE); for (int it = C.gw; it < MTOK * 4; it += C.ngw) fa::dil_fixup(OCAT, LSE, it, lane); }
#endif
#if USE_FA_NSA
            { __syncthreads(); const fa::Ids I = fa::make_ids(C.wave, C.lane); const unsigned long long* SELp = PWS(unsigned long long, WS_SEL); float* ACC = PWS(float, WS_OCMP); const bf16* KVCp = PWS(bf16, WS_KVC);
              { const int xq = (int)(xb_xcc_id() & 7u); int cleft = DEFER_CONV; asm volatile("" : "+s"(cleft));
                for (int qi = 0; qi < 8; ++qi) { const int q = (xq + qi) & 7;
                  for (;;) {
                      if (C.wave == 0 && fresh_lane() == 0) F.MISC[52] = __hip_atomic_fetch_add(PWS(unsigned, WS_CTL) + 240000 + 64 * (L * 8 + q), 1u, __ATOMIC_RELAXED, __HIP_MEMORY_SCOPE_AGENT);
                      __syncthreads(); const int e = (int)__builtin_amdgcn_readfirstlane((int)F.MISC[52]); __syncthreads();
                      if (e >= 48) break;
                      const int combo = (e / 6) * 8 + q, blk = 15 - (combo >> 2), bg = combo & 3, hq = (bg & 1) * 6 + e % 6, bq = bg >> 1;
                      const fa::Ids I = fa::make_ids_op(C.wave, fresh_lane());
                      const bf16* PROJ_ = PROJ; const unsigned long long* SEL_ = SELp; float* ACC_ = ACC; bf16* OCAT_ = OCAT; const bf16* KVC_ = KVCp; asm volatile("" : "+s"(PROJ_), "+s"(SEL_), "+s"(ACC_), "+s"(OCAT_), "+s"(KVC_));
                      fa::nsa_unit(PROJ_, KVC_, SEL_, ACC_, OCAT_, bq, hq, blk * 256, C.lds + RING_OFF, I, F.MISC);
                      if (DEFER_CONV) {
#pragma unroll 1
                          for (int p_ = 0; p_ < CVQ_P1 && cleft; ++p_) cleft = conv_chunk<4>(F, C, 2 * L + 1) ? 1 : 0; } } }
                if (DEFER_CONV) {
#pragma unroll 1
                    while (cleft) cleft = conv_chunk<4>(F, C, 2 * L + 1) ? 1 : 0; } } }
#else
            for (int it = C.gw; it < BATCH * SEQ * 12; it += C.ngw) nsa_item(PROJ, PWS(bf16, WS_KVC), OCMP, SEL, OCAT, it, QS, PS, lane);
#endif

            SEAM(pb + 3);
        }
        if (IN(pb + 4)) {
            CTX();
            pg8::Gemm g{PWS(bf16, WS_OCAT), PWS(bf16, WS_WOUT) + (size_t)L * DM * DM, MTOK, DM, DM}; pg8::StaticOrder S; S.init(MTOK, DM, C.G, C.bid);
            { float* KC = PWS(float, WS_KC); for (int e = C.gw * 64 + C.lane; e < 2 * 2 * 256 * 128; e += C.ngw * 64) KC[e] = 0.f; }
            pg8::EpiResidB E{PWS(bf16, WS_H), DM, PWS(float, WS_SS) + (size_t)(2 * L + 1) * 2 * MTOK, L == 0 ? PIN(0) : nullptr};
            pg8::gemm_phase<pg8::EpiResidB, pg8::StaticOrder, true, true>(C.lds + RING_OFF, g, S, E, C.wave);

            SEAM(pb + 4);

        }
        if (IN(pb + 6)) {
            CTX();
            pg8::Gemm g{PWS(bf16, WS_H), PWS(bf16, WS_WUP) + (size_t)L * DFF * DM, MTOK, DFF, DM}; pg8::StaticOrder S; S.init(MTOK, DFF, C.G, C.bid);
            pg8::EpiRelu2 E{PWS(bf16, WS_U), DFF, PWS(float, WS_SS) + (size_t)(2 * L + 1) * 2 * MTOK};
            for (int rep_ = 0; rep_ < NREP(6); ++rep_) pg8::gemm_phase<pg8::EpiRelu2, pg8::StaticOrder, true, true>(C.lds + RING_OFF, g, S, E, C.wave);

            SEAM(pb + 6);

        }
        if (IN(pb + 7)) {
            CTX();
            pg8::Gemm g{PWS(bf16, WS_U), PWS(bf16, WS_WDN) + (size_t)L * DM * DFF, MTOK, DM, DFF}; pg8::StaticOrder S; S.init(MTOK, DM, C.G, C.bid);
            pg8::EpiResidB E{PWS(bf16, WS_H), DM, PWS(float, WS_SS) + (size_t)(2 * L + 2) * 2 * MTOK, nullptr};
            pg8::gemm_phase<pg8::EpiResidB, pg8::StaticOrder, true, true>(C.lds + RING_OFF, g, S, E, C.wave);

            SEAM(pb + 7);

        }
        if (L + 1 == DEPTH && IN(pb + 8)) {
            CTX();
            norm_phase_b(C, PWS(bf16, WS_H), PIN(13), (float*)rd_ptr(F, PT_OUT));
            SEAM(pb + 8);
        }
}

struct Args { const float* in[14]; float* out; unsigned char* ws; int ph_lo, ph_hi; };
__global__ void __launch_bounds__(NWAVES * 64, 2) mega_fwd(Args args) {
    extern __shared__ __attribute__((aligned(16))) unsigned char lds[];
    Frame F;
    F.lds = (LAS unsigned char*)lds; F.MISC = (volatile LAS unsigned*)(F.lds + MISC_OFF);
    F.wave = __builtin_amdgcn_readfirstlane((int)(threadIdx.x >> 6));
    if (threadIdx.x < 64) ((LAS unsigned*)(F.lds + MISC_OFF))[threadIdx.x] = 0u;
    __syncthreads();
    if (threadIdx.x == 0) {
#pragma unroll
        for (int k = 0; k < 16; ++k) { const unsigned long long p = k < 14 ? (unsigned long long)args.in[k < 14 ? k : 0] : (k == 14 ? (unsigned long long)args.out : (unsigned long long)args.ws);
            F.MISC[16 + 2 * k] = (unsigned)p; F.MISC[17 + 2 * k] = (unsigned)(p >> 32); } }
    if (threadIdx.x == 0) { F.MISC[53] = (unsigned)args.ph_lo; F.MISC[54] = (unsigned)args.ph_hi; }
    __syncthreads();
    (void)xcd_barrier_post(PWS(unsigned, WS_CTL) + CW_BAR + PH_LO() * XCD_BAR_WORDS, F.MISC + 8);

    if (PROBE_T && threadIdx.x == 0) { const unsigned long long now_ = wall_clock64(); F.MISC[48] = (unsigned)now_; F.MISC[49] = (unsigned)(now_ >> 32); F.MISC[50] = 0u; }
#ifndef NO_PRO
    if (IN(0)) { CTX(); p0_prologue(F, C); SEAM(0); }
#endif
#if PROBE_SEC
    if (threadIdx.x == 0) F.MISC[54] = 2u; __syncthreads();
    layer_phases<0>(F);
    __syncthreads(); if (threadIdx.x == 0) F.MISC[54] = (unsigned)args.ph_hi; __syncthreads();
    probe_phases(F);
#else
    layer_phases<0>(F);
    layer_phases<1>(F);
#endif
#if PROBE_N
    { XcdBarrier b_; b_.bar = PWS(unsigned, WS_CTL) + CW_BAR + PH_LO() * XCD_BAR_WORDS; b_.x = xb_xcc_id(); b_.st = F.MISC + 8; xcd_barrier(b_);
      if (blockIdx.x == 0 && threadIdx.x == 0) { const unsigned long long* tsb = (const unsigned long long*)(rd_ptr(F, PT_WS)) + TS_BASE + 600;
          const unsigned long long v = __hip_atomic_load(tsb + (PROBE_N - 1), __ATOMIC_RELAXED, __HIP_MEMORY_SCOPE_AGENT) / gridDim.x;
          const unsigned long long t0 = wall_clock64(); while (wall_clock64() - t0 < (unsigned long long)PROBE_K * v) __builtin_amdgcn_s_sleep(8); } }
#endif
#if PROBE_T
    { TSTAMP(); XcdBarrier b_; b_.bar = PWS(unsigned, WS_CTL) + CW_BAR + PH_LO() * XCD_BAR_WORDS; b_.x = xb_xcc_id(); b_.st = F.MISC + 8; xcd_barrier(b_);
      if (blockIdx.x == 0 && threadIdx.x == 0) { const unsigned long long* tsb = (const unsigned long long*)(rd_ptr(F, PT_WS)) + TS_BASE; unsigned long long v = 0;
          if (PROBE_T == 999) { const int ns_ = (int)F.MISC[50]; for (int s = 1; s < ns_; s += 2) v += __hip_atomic_load(tsb + s, __ATOMIC_RELAXED, __HIP_MEMORY_SCOPE_AGENT) / gridDim.x; }
          else if (PROBE_T > 100) v = __hip_atomic_load(tsb + 256 + (PROBE_T - 101), __ATOMIC_RELAXED, __HIP_MEMORY_SCOPE_AGENT);
          else v = __hip_atomic_load(tsb + (PROBE_T - 1), __ATOMIC_RELAXED, __HIP_MEMORY_SCOPE_AGENT) / gridDim.x;
          const unsigned long long t0 = wall_clock64(); while (wall_clock64() - t0 < (unsigned long long)PROBE_K * v) __builtin_amdgcn_s_sleep(8); } }
#endif
}

extern "C" void kernel_launch(void* const* d_in, const int* in_sizes, int n_in, void* d_out, int out_size, void* d_ws, size_t ws_size, hipStream_t stream) {
    static int grid = 0;
    if (grid == 0) {
        if (n_in != 14 || in_sizes[0] != MTOK * DM || out_size != MTOK * DM || ws_size < WS_END) {
            fprintf(stderr, "kernel_launch: unexpected shapes (n_in %d, in0 %d, out %d, ws %zu; need ws >= %zu); nothing launched\n", n_in, n_in > 0 ? in_sizes[0] : -1, out_size, ws_size, (size_t)WS_END); grid = -1; return; }
        int dev = 0, cus = 0, per_cu = 0;
        if (hipGetDevice(&dev) != hipSuccess || hipDeviceGetAttribute(&cus, hipDeviceAttributeMultiprocessorCount, dev) != hipSuccess) { fprintf(stderr, "kernel_launch: device query failed\n"); grid = -1; return; }
        if (hipFuncSetAttribute((const void*)mega_fwd, hipFuncAttributeMaxDynamicSharedMemorySize, LDS_BYTES) != hipSuccess) { fprintf(stderr, "kernel_launch: hipFuncSetAttribute failed\n"); grid = -1; return; }
        if (hipOccupancyMaxActiveBlocksPerMultiprocessor(&per_cu, (const void*)mega_fwd, NWAVES * 64, LDS_BYTES) != hipSuccess || per_cu < 1)
            fprintf(stderr, "kernel_launch: note: occupancy query reports %d workgroups per CU\n", per_cu);
        (void)hipGetLastError();
        grid = cus;
    }
    if (grid < 0) return;
    if (hipMemsetAsync((char*)d_ws + WS_CTL, 0, CTL_ZERO_BYTES, stream) != hipSuccess) { fprintf(stderr, "kernel_launch: memset failed\n"); return; }
    Args a{};
    for (int i = 0; i < 14; ++i) a.in[i] = (const float*)d_in[i];
    a.out = (float*)d_out; a.ws = (unsigned char*)d_ws;
#if PROBE_SEC
    a.ph_lo = 0; a.ph_hi = 6;
    hipLaunchKernelGGL(mega_fwd, dim3(grid), dim3(NWAVES * 64), LDS_BYTES, stream, a);
#elif MK_ONE_LAUNCH
    a.ph_lo = 0; a.ph_hi = NPH;
    hipLaunchKernelGGL(mega_fwd, dim3(grid), dim3(NWAVES * 64), LDS_BYTES, stream, a);
#else
    for (int ph = 0; ph < NPH; ++ph) { a.ph_lo = ph; a.ph_hi = ph + 1;
        hipLaunchKernelGGL(mega_fwd, dim3(grid), dim3(NWAVES * 64), LDS_BYTES, stream, a); }
#endif
    const hipError_t le = hipPeekAtLastError();
    if (le != hipSuccess) fprintf(stderr, "kernel_launch: launch failed: %s\n", hipGetErrorName(le));
}
```

```cpp
#include <hip/hip_runtime.h>
#include <cstdio>
#include <cstdint>
#ifndef PROBE_SEC
#define PROBE_SEC 0
#endif
#ifndef NT_U
#define NT_U 0
#endif
constexpr float FX_SS = 16777216.0f, FX_SS_INV = 1.0f / 16777216.0f, FX_KC = 4294967296.0f, FX_KC_INV = 1.0f / 4294967296.0f;
__device__ __forceinline__ void fx_add(float* slot, float v, float scale) { atomicAdd((unsigned long long*)slot, (unsigned long long)__float2ll_rn(v * scale)); }
__device__ __forceinline__ void fx_put(float* slot, float v, float scale) { *(long long*)slot = __float2ll_rn(v * scale); }
__device__ __forceinline__ float fx_get(const float* slot, float inv) { return (float)(*(const long long*)slot) * inv; }
namespace pg8 {
#define PG8_LAS __attribute__((address_space(3)))
typedef unsigned short bf16_t;
typedef short bf16x8 __attribute__((ext_vector_type(8)));
typedef float f32x4 __attribute__((ext_vector_type(4)));
typedef unsigned u32x4 __attribute__((ext_vector_type(4)));
constexpr int BM = 256, BK = 64, HALF = 128, HTB = HALF * BK * 2  , STAGE_BYTES = 8 * HTB, NXCD = 8, WGM = 8;

__host__ __device__ __forceinline__ int lds_byte(int r, int c) { const int st = (r >> 4) * 2 + (c >> 5), rr = r & 15, cc = c & 31, ob = rr * 64 + cc * 2; return st * 1024 + (ob ^ (((ob >> 9) & 1) << 5)); }
__host__ __device__ __forceinline__ void stage_rc(int b, int& R, int& C) { const int st = b / 1024, sb = b % 1024, swz = sb ^ (((sb >> 9) & 1) << 5); R = (st >> 1) * 16 + swz / 64; C = (st & 1) * 32 + (swz % 64) / 2; }
__host__ __device__ __forceinline__ int perm32(int rho) { const int n = rho >> 4, i = rho & 15; return 8 * (i >> 2) + 4 * n + (i & 3); }

struct Unit { int pm, pn; };
struct Gemm { const bf16_t* A; const bf16_t* Bt; int M, N, K; };

struct StaticOrder {
    int nM, nN, nwg, G, c;
    __host__ __device__ void init(int M, int N, int G_, int c_) { nM = M / BM; nN = N / BM; nwg = nM * nN; G = G_; c = c_; }
    __host__ __device__ bool next(int i, Unit& u) const {
        const long L = (long)i * G + c; if (L >= nwg) return false;
        int wgid = (int)L; { const int q = nwg / NXCD, r = nwg % NXCD, xcd = wgid % NXCD, off = wgid / NXCD; wgid = (xcd < r ? xcd * (q + 1) : r * (q + 1) + (xcd - r) * q) + off; }
        const int nig = WGM * nN, gid = wgid / nig, fm = gid * WGM, gsz = (nM - fm) < WGM ? (nM - fm) : WGM;
        u.pm = fm + ((wgid % nig) % gsz); u.pn = (wgid % nig) / gsz; return true;
    }
    __device__ __forceinline__ void a_ready(const Unit&) const {}
    __device__ __forceinline__ void done(const Unit&) const {}
};

__device__ __forceinline__ unsigned cvt_pk_bf16(float lo, float hi) { unsigned r; asm volatile("v_cvt_pk_bf16_f32 %0, %1, %2" : "=v"(r) : "v"(lo), "v"(hi)); return r; }
typedef unsigned u32x2 __attribute__((ext_vector_type(2)));
constexpr float SCL2 = 0.12751743082459868f;
struct EpiProj {
    static constexpr bool PERM = true, AFTER_DRAIN = false;
    bf16_t* O; int ldc; const float* cosT; const float* sinT; int seq; const float* ss; bf16_t* kvc; int mtok; int pn0;
    __device__ __forceinline__ void operator()(const f32x4 (&acc)[2][2][4][2], const Unit& u, int wr, int wc, int fr, int fq) const {
        const int row0 = u.pm * BM + wr * 64 + fr, pn = u.pn + pn0;
        const bool scaled = (pn < 6) || (pn >= 9 && pn < 15) || (pn >= 30 && pn < 34);
        const float sc = scaled ? SCL2 : 1.0f;
        if (pn < 21) {
            const int j = 4 * wc + fq;
#pragma unroll
            for (int ai = 0; ai < 2; ++ai)
#pragma unroll
                for (int m = 0; m < 4; ++m) { const int row = row0 + ai * HALF + m * 16, t = row & (seq - 1); const float rs = sc * (1.0f / sqrtf(fx_get(ss + 2 * row, FX_SS_INV) * (1.0f / 4096.0f) + 1e-6f));
                    const f32x4 c4 = *(const f32x4*)(cosT + t * 64 + 4 * j), s4 = *(const f32x4*)(sinT + t * 64 + 4 * j);
                    const bool cmp_ = (pn == 7 || pn == 8);
                    bf16_t* rowp = cmp_ ? kvc + ((size_t)((pn - 7) * 2) * mtok + row) * 128 : O + (size_t)row * ldc + pn * BM; const size_t hstep_ = cmp_ ? (size_t)mtok * 128 : (size_t)HALF;
#pragma unroll
                    for (int bj = 0; bj < 2; ++bj) { const f32x4 x1 = acc[ai][bj][m][0] * rs, x2 = acc[ai][bj][m][1] * rs;
                        const f32x4 o1 = x1 * c4 - x2 * s4, o2 = x1 * s4 + x2 * c4;
                        u32x2 w1, w2; w1.x = cvt_pk_bf16(o1[0], o1[1]); w1.y = cvt_pk_bf16(o1[2], o1[3]); w2.x = cvt_pk_bf16(o2[0], o2[1]); w2.y = cvt_pk_bf16(o2[2], o2[3]);
                        *(u32x2*)(rowp + bj * hstep_ + 4 * j) = w1; *(u32x2*)(rowp + bj * hstep_ + 64 + 4 * j) = w2;
#if PROBE_SEC == 5
                        if (cmp_) { bf16_t* r2 = O + (size_t)row * ldc + pn * BM; *(u32x2*)(r2 + bj * HALF + 4 * j) = w1; *(u32x2*)(r2 + bj * HALF + 64 + 4 * j) = w2; }
#endif
                    } }
        } else {
            const int col0 = pn * BM + wc * 32 + 8 * fq;
#pragma unroll
            for (int ai = 0; ai < 2; ++ai)
#pragma unroll
                for (int m = 0; m < 4; ++m) { const int row = row0 + ai * HALF + m * 16; const bool cmp_ = (pn == 22 || pn == 23);
                    bf16_t* rowp = cmp_ ? kvc + ((size_t)((pn - 20) * 2) * mtok + row) * 128 + wc * 32 + 8 * fq : O + (size_t)row * ldc + col0; const size_t hstep_ = cmp_ ? (size_t)mtok * 128 : (size_t)HALF;
                    const float rs = sc * (1.0f / sqrtf(fx_get(ss + 2 * row, FX_SS_INV) * (1.0f / 4096.0f) + 1e-6f));
#pragma unroll
                    for (int bj = 0; bj < 2; ++bj) { const f32x4 v0 = acc[ai][bj][m][0] * rs, v1 = acc[ai][bj][m][1] * rs;
                        u32x4 w; w.x = cvt_pk_bf16(v0[0], v0[1]); w.y = cvt_pk_bf16(v0[2], v0[3]); w.z = cvt_pk_bf16(v1[0], v1[1]); w.w = cvt_pk_bf16(v1[2], v1[3]);
                        *(u32x4*)(rowp + bj * hstep_) = w;
#if PROBE_SEC == 5
                        if (cmp_) *(u32x4*)(O + (size_t)row * ldc + col0 + bj * HALF) = w;
#endif
                    } }
        }
    }
};
struct EpiResid {
    static constexpr bool PERM = false, AFTER_DRAIN = false;
    const float* base; float* out; int ldc; bf16_t* xb; float* ss;
    __device__ __forceinline__ void operator()(const f32x4 (&acc)[2][2][4][2], const Unit& u, int wr, int wc, int fr, int fq) const {
        const int row0 = u.pm * BM + wr * 64 + fr, col0 = u.pn * BM + wc * 32 + 4 * fq;
#pragma unroll
        for (int ai = 0; ai < 2; ++ai)
#pragma unroll
            for (int m = 0; m < 4; ++m) { const int row = row0 + ai * HALF + m * 16; const size_t off = (size_t)row * ldc + col0;
                f32x4 b[2][2]; float q = 0.f;
#pragma unroll
                for (int bj = 0; bj < 2; ++bj)
#pragma unroll
                    for (int n = 0; n < 2; ++n) b[bj][n] = *(const f32x4*)(base + off + bj * HALF + n * 16);
#pragma unroll
                for (int bj = 0; bj < 2; ++bj)
#pragma unroll
                    for (int n = 0; n < 2; ++n) { const f32x4 o = b[bj][n] + acc[ai][bj][m][n]; *(f32x4*)(out + off + bj * HALF + n * 16) = o;
                        if (xb) { u32x2 w; w.x = cvt_pk_bf16(o[0], o[1]); w.y = cvt_pk_bf16(o[2], o[3]); *(u32x2*)(xb + off + bj * HALF + n * 16) = w; q += (o[0] * o[0] + o[1] * o[1]) + (o[2] * o[2] + o[3] * o[3]); } }
                if (xb) { q += __shfl_xor(q, 16); q += __shfl_xor(q, 32); if (fq == 0) unsafeAtomicAdd(ss + row, q); }
                asm volatile("" ::: "memory"); }
    }
};
struct EpiResid2 {
    static constexpr bool PERM = true, AFTER_DRAIN = false;
    bf16_t* hi; bf16_t* lo; int ldc; float* ss; const float* base32;
    __device__ __forceinline__ void operator()(const f32x4 (&acc)[2][2][4][2], const Unit& u, int wr, int wc, int fr, int fq) const {
        const int row0 = u.pm * BM + wr * 64 + fr, col0 = u.pn * BM + wc * 32 + 8 * fq;
#pragma unroll
        for (int ai = 0; ai < 2; ++ai)
#pragma unroll
            for (int m = 0; m < 4; ++m) { const int row = row0 + ai * HALF + m * 16; const size_t off = (size_t)row * ldc + col0; float q = 0.f;
                u32x4 bh[2], bl[2];
                if (base32) {
#pragma unroll
                    for (int bj = 0; bj < 2; ++bj) { bh[bj] = *(const u32x4*)(base32 + off + bj * HALF); bl[bj] = *(const u32x4*)(base32 + off + bj * HALF + 4); }
                } else {
#pragma unroll
                    for (int bj = 0; bj < 2; ++bj) { bh[bj] = *(const u32x4*)(hi + off + bj * HALF); bl[bj] = *(const u32x4*)(lo + off + bj * HALF); } }
#pragma unroll
                for (int bj = 0; bj < 2; ++bj) { f32x4 v0 = acc[ai][bj][m][0], v1 = acc[ai][bj][m][1]; u32x4 wh, wl;
                    if (base32) { v0[0] += __uint_as_float(bh[bj].x); v0[1] += __uint_as_float(bh[bj].y); v0[2] += __uint_as_float(bh[bj].z); v0[3] += __uint_as_float(bh[bj].w);
                                  v1[0] += __uint_as_float(bl[bj].x); v1[1] += __uint_as_float(bl[bj].y); v1[2] += __uint_as_float(bl[bj].z); v1[3] += __uint_as_float(bl[bj].w);
                                  bh[bj] = (u32x4){0u, 0u, 0u, 0u}; bl[bj] = (u32x4){0u, 0u, 0u, 0u}; }
#define PG8_R2(V, E0, HW, LW, OH, OL) do { \
                    const float x0_ = (__uint_as_float(HW << 16) + __uint_as_float(LW << 16)) + V[E0], x1_ = (__uint_as_float(HW & 0xffff0000u) + __uint_as_float(LW & 0xffff0000u)) + V[E0 + 1]; \
                    q += x0_ * x0_ + x1_ * x1_; OH = cvt_pk_bf16(x0_, x1_); \
                    OL = cvt_pk_bf16(x0_ - __uint_as_float(OH << 16), x1_ - __uint_as_float(OH & 0xffff0000u)); } while (0)
                    PG8_R2(v0, 0, bh[bj].x, bl[bj].x, wh.x, wl.x); PG8_R2(v0, 2, bh[bj].y, bl[bj].y, wh.y, wl.y);
                    PG8_R2(v1, 0, bh[bj].z, bl[bj].z, wh.z, wl.z); PG8_R2(v1, 2, bh[bj].w, bl[bj].w, wh.w, wl.w);
#undef PG8_R2
                    *(u32x4*)(hi + off + bj * HALF) = wh; *(u32x4*)(lo + off + bj * HALF) = wl; }
                q += __shfl_xor(q, 16); q += __shfl_xor(q, 32); if (fq == 0) unsafeAtomicAdd(ss + row, q);
                asm volatile("" ::: "memory"); }
    }
};
struct EpiResidB {
    static constexpr bool PERM = true, AFTER_DRAIN = false;
    bf16_t* x; int ldc; float* ss; const float* base32;
    __device__ __forceinline__ void operator()(const f32x4 (&acc)[2][2][4][2], const Unit& u, int wr, int wc, int fr, int fq) const {
        const int row0 = u.pm * BM + wr * 64 + fr, col0 = u.pn * BM + wc * 32 + 8 * fq;
#pragma unroll
        for (int ai = 0; ai < 2; ++ai)
#pragma unroll
            for (int m = 0; m < 4; ++m) { const int row = row0 + ai * HALF + m * 16; const size_t off = (size_t)row * ldc + col0; float q = 0.f;
                f32x4 b0[2], b1[2];
                if (base32) {
#pragma unroll
                    for (int bj = 0; bj < 2; ++bj) { b0[bj] = __builtin_nontemporal_load((const f32x4*)(base32 + off + bj * HALF)); b1[bj] = __builtin_nontemporal_load((const f32x4*)(base32 + off + bj * HALF + 4)); }
                } else {
#pragma unroll
                    for (int bj = 0; bj < 2; ++bj) { const u32x4 w = *(const u32x4*)(x + off + bj * HALF);
                        b0[bj] = (f32x4){__uint_as_float(w.x << 16), __uint_as_float(w.x & 0xffff0000u), __uint_as_float(w.y << 16), __uint_as_float(w.y & 0xffff0000u)};
                        b1[bj] = (f32x4){__uint_as_float(w.z << 16), __uint_as_float(w.z & 0xffff0000u), __uint_as_float(w.w << 16), __uint_as_float(w.w & 0xffff0000u)}; } }
#pragma unroll
                for (int bj = 0; bj < 2; ++bj) { const f32x4 v0 = b0[bj] + acc[ai][bj][m][0], v1 = b1[bj] + acc[ai][bj][m][1];
                    q += ((v0[0] * v0[0] + v0[1] * v0[1]) + (v0[2] * v0[2] + v0[3] * v0[3])) + ((v1[0] * v1[0] + v1[1] * v1[1]) + (v1[2] * v1[2] + v1[3] * v1[3]));
                    u32x4 w; w.x = cvt_pk_bf16(v0[0], v0[1]); w.y = cvt_pk_bf16(v0[2], v0[3]); w.z = cvt_pk_bf16(v1[0], v1[1]); w.w = cvt_pk_bf16(v1[2], v1[3]);
                    *(u32x4*)(x + off + bj * HALF) = w; }
                q += __shfl_xor(q, 16); q += __shfl_xor(q, 32); if (fq == 0) fx_add(ss + 2 * row, q, FX_SS);
                asm volatile("" ::: "memory"); }
    }
};
struct EpiRelu2 {
    static constexpr bool PERM = true, AFTER_DRAIN = false;
    bf16_t* O; int ldc; const float* ss;
    __device__ __forceinline__ void operator()(const f32x4 (&acc)[2][2][4][2], const Unit& u, int wr, int wc, int fr, int fq) const {
        const int row0 = u.pm * BM + wr * 64 + fr, col0 = u.pn * BM + wc * 32 + 8 * fq;
#pragma unroll
        for (int ai = 0; ai < 2; ++ai)
#pragma unroll
            for (int m = 0; m < 4; ++m) { const int row = row0 + ai * HALF + m * 16; bf16_t* rowp = O + (size_t)row * ldc + col0; const float r2 = 1.0f / (fx_get(ss + 2 * row, FX_SS_INV) * (1.0f / 4096.0f) + 1e-6f);
#pragma unroll
                for (int bj = 0; bj < 2; ++bj) { f32x4 v0 = acc[ai][bj][m][0], v1 = acc[ai][bj][m][1];
#pragma unroll
                    for (int e = 0; e < 4; ++e) { const float a = fmaxf(v0[e], 0.f), b = fmaxf(v1[e], 0.f); v0[e] = a * a * r2; v1[e] = b * b * r2; }
                    u32x4 w; w.x = cvt_pk_bf16(v0[0], v0[1]); w.y = cvt_pk_bf16(v0[2], v0[3]); w.z = cvt_pk_bf16(v1[0], v1[1]); w.w = cvt_pk_bf16(v1[2], v1[3]);
#if NT_U
                    __builtin_nontemporal_store(w, (u32x4*)(rowp + bj * HALF));
#else
                    *(u32x4*)(rowp + bj * HALF) = w;
#endif
                } }
    }
};

template <int MODE> struct MapOrder : StaticOrder {
    __host__ __device__ bool next(int i, Unit& u) const { if (!StaticOrder::next(i, u)) return false;
        u.pn = MODE == 1 ? u.pn + (u.pn >= 7 ? 2 : 0) + (u.pn >= 20 ? 1 : 0) : (u.pn == 0 ? 7 : u.pn == 1 ? 8 : 22); return true; }
};
template <class Epi, class Sched, bool ALIGN_EPI = false, bool SP2 = false>
__device__ __forceinline__ void gemm_phase(PG8_LAS unsigned char* lds, const Gemm g, const Sched& S, const Epi& E, const int wid_in) {
    int lane = (int)__builtin_amdgcn_mbcnt_hi(~0u, __builtin_amdgcn_mbcnt_lo(~0u, 0u)); asm volatile("" : "+v"(lane));
    const int wid = wid_in, tid = wid * 64 + lane, wr = wid >> 2, wc = wid & 3, fr = lane & 15, fq = lane >> 4;
    const int K = g.K, nt = K / BK;
    unsigned voffA[2], voffB[2];
#pragma unroll
    for (int i = 0; i < 2; ++i) { int R, C; stage_rc(tid * 16 + i * 8192, R, C); const int Rb = Epi::PERM ? ((R & ~31) + perm32(R & 31)) : R;
        voffA[i] = (unsigned)(R * K + C) * 2u; voffB[i] = (unsigned)(Rb * K + C) * 2u; }
    const size_t kstep = (size_t)(BK * 2);
    const size_t hstep = (size_t)HALF * K * 2;
    const size_t tstep = 2 * hstep;
    const unsigned ldsw = (unsigned)wid * 1024u;
    const int aoff = lds_byte(wr * 64 + fr, fq * 8), boff = lds_byte(wc * 32 + fr, fq * 8);
#define PG8_SA(b, h) (((b) * 2 + (h)) * HTB)
#define PG8_SB(b, h) ((4 + (b) * 2 + (h)) * HTB)
#define PG8_STAGE(bufoff, gbase, voff) do { _Pragma("unroll") for (int _i = 0; _i < 2; ++_i) \
        __builtin_amdgcn_global_load_lds((const unsigned*)((const char*)(gbase) + (voff)[_i]), (PG8_LAS unsigned*)(lds + (bufoff) + ldsw + _i * 8192), 16, 0, 0); } while (0)
#define PG8_LDA(dst, b, h) do { _Pragma("unroll") for (int m = 0; m < 4; ++m) _Pragma("unroll") for (int k = 0; k < 2; ++k) dst[m][k] = *(const PG8_LAS bf16x8*)(lds + PG8_SA(b, h) + aoff + m * 2048 + k * 1024); } while (0)
#define PG8_LDB(dst, b, h) do { _Pragma("unroll") for (int n = 0; n < 2; ++n) _Pragma("unroll") for (int k = 0; k < 2; ++k) dst[n][k] = *(const PG8_LAS bf16x8*)(lds + PG8_SB(b, h) + boff + n * 2048 + k * 1024); } while (0)
#define PG8_MMA(ai, bj, At, Bt) do { __builtin_amdgcn_s_setprio(1); _Pragma("unroll") for (int m = 0; m < 4; ++m) _Pragma("unroll") for (int n = 0; n < 2; ++n) _Pragma("unroll") for (int k = 0; k < 2; ++k) \
        acc[ai][bj][m][n] = __builtin_amdgcn_mfma_f32_16x16x32_bf16(Bt[n][k], At[m][k], acc[ai][bj][m][n], 0, 0, 0); __builtin_amdgcn_s_setprio(0); } while (0)
#define PG8_WAIT_V(n) asm volatile("s_waitcnt vmcnt(" #n ")" ::: "memory")
#define PG8_WAIT_L(n) asm volatile("s_waitcnt lgkmcnt(" #n ")" ::: "memory")
#define PG8_BAR __builtin_amdgcn_s_barrier()
#define PG8_SCHED __builtin_amdgcn_sched_barrier(0)
    Unit cur, nxt; int ui = 0;
    if (!S.next(0, cur)) return;
    f32x4 acc[2][2][4][2];
#pragma unroll
    for (int a = 0; a < 2; ++a)
#pragma unroll
        for (int b = 0; b < 2; ++b)
#pragma unroll
            for (int m = 0; m < 4; ++m)
#pragma unroll
                for (int n = 0; n < 2; ++n) acc[a][b][m][n] = (f32x4){0.f, 0.f, 0.f, 0.f};
    bf16x8 At[4][2], B0[2][2], B1[2][2];
    const char* cA = (const char*)g.A + (size_t)cur.pm * tstep; const char* cB = (const char*)g.Bt + (size_t)cur.pn * tstep;
    S.a_ready(cur);
    if constexpr (SP2) {
        PG8_STAGE(PG8_SB(0, 0), cB, voffB); PG8_STAGE(PG8_SB(0, 1), cB + hstep, voffB); PG8_STAGE(PG8_SA(0, 0), cA, voffA); PG8_STAGE(PG8_SA(0, 1), cA + hstep, voffA);
        if (wr == 1) PG8_BAR;
        PG8_WAIT_V(2); PG8_BAR;
        PG8_STAGE(PG8_SB(1, 0), cB + kstep, voffB); PG8_STAGE(PG8_SA(1, 0), cA + kstep, voffA); PG8_STAGE(PG8_SB(1, 1), cB + hstep + kstep, voffB);
        PG8_WAIT_V(6); PG8_BAR;
    } else {
        PG8_STAGE(PG8_SB(0, 0), cB, voffB); PG8_STAGE(PG8_SA(0, 0), cA, voffA); PG8_STAGE(PG8_SB(0, 1), cB + hstep, voffB); PG8_STAGE(PG8_SA(0, 1), cA + hstep, voffA);
        if (wr == 1) PG8_BAR;
        PG8_WAIT_V(4); PG8_BAR;
        PG8_STAGE(PG8_SB(1, 0), cB + kstep, voffB); PG8_STAGE(PG8_SA(1, 0), cA + kstep, voffA); PG8_STAGE(PG8_SB(1, 1), cB + hstep + kstep, voffB);
        PG8_WAIT_V(6); PG8_BAR;
    }
    for (;;) {
        const bool has_next = S.next(ui + 1, nxt);
        const char* nA = has_next ? (const char*)g.A + (size_t)nxt.pm * tstep : cA; const char* nB = has_next ? (const char*)g.Bt + (size_t)nxt.pn * tstep : cB;
        for (int t = 0; t < nt; t += 2) {
            const bool last = (t == nt - 2);
            const char* a1 = cA + (size_t)(t + 1) * kstep;
            const char* a2 = last ? nA : cA + (size_t)(t + 2) * kstep; const char* b2 = last ? nB : cB + (size_t)(t + 2) * kstep;
            const char* a3 = a2 + kstep; const char* b3 = b2 + kstep;
            if (last && has_next) S.a_ready(nxt);
            if constexpr (SP2) {
            PG8_LDB(B0, 0, 0); PG8_LDB(B1, 0, 1); PG8_SCHED; PG8_LDA(At, 0, 0); PG8_STAGE(PG8_SA(1, 1), a1 + hstep, voffA);
            PG8_WAIT_V(8); PG8_WAIT_L(0); PG8_BAR; PG8_MMA(0, 0, At, B0); PG8_MMA(0, 1, At, B1); PG8_BAR; PG8_SCHED;
            PG8_LDA(At, 0, 1); PG8_STAGE(PG8_SB(0, 0), b2, voffB); PG8_STAGE(PG8_SB(0, 1), b2 + hstep, voffB); PG8_STAGE(PG8_SA(0, 0), a2, voffA);
            PG8_WAIT_V(8); PG8_WAIT_L(0); PG8_BAR; PG8_MMA(1, 0, At, B0); PG8_MMA(1, 1, At, B1); PG8_BAR; PG8_SCHED;
            PG8_LDB(B0, 1, 0); PG8_LDB(B1, 1, 1); PG8_SCHED; PG8_LDA(At, 1, 0); PG8_STAGE(PG8_SA(0, 1), a2 + hstep, voffA);
            PG8_WAIT_V(8); PG8_WAIT_L(0); PG8_BAR; PG8_MMA(0, 0, At, B0); PG8_MMA(0, 1, At, B1); PG8_BAR; PG8_SCHED;
            PG8_LDA(At, 1, 1); PG8_STAGE(PG8_SB(1, 0), b3, voffB); PG8_STAGE(PG8_SB(1, 1), b3 + hstep, voffB); PG8_STAGE(PG8_SA(1, 0), a3, voffA);
            PG8_WAIT_V(8); PG8_WAIT_L(0); PG8_BAR; PG8_MMA(1, 0, At, B0); PG8_MMA(1, 1, At, B1); PG8_BAR; PG8_SCHED;
            } else {
            PG8_LDB(B0, 0, 0); PG8_SCHED; PG8_LDA(At, 0, 0); PG8_STAGE(PG8_SA(1, 1), a1 + hstep, voffA);
            PG8_WAIT_L(8); PG8_BAR; PG8_WAIT_L(0); PG8_MMA(0, 0, At, B0); PG8_BAR; PG8_SCHED;
            PG8_LDB(B1, 0, 1); PG8_STAGE(PG8_SB(0, 0), b2, voffB);
            PG8_BAR; PG8_WAIT_L(0); PG8_MMA(0, 1, At, B1); PG8_BAR;
            PG8_LDA(At, 0, 1); PG8_STAGE(PG8_SA(0, 0), a2, voffA);
            PG8_BAR; PG8_WAIT_L(0); PG8_MMA(1, 0, At, B0); PG8_BAR; PG8_SCHED;
            PG8_STAGE(PG8_SB(0, 1), b2 + hstep, voffB);
            PG8_WAIT_V(6); PG8_BAR; PG8_MMA(1, 1, At, B1); PG8_BAR;
            PG8_LDB(B0, 1, 0); PG8_SCHED; PG8_LDA(At, 1, 0); PG8_STAGE(PG8_SA(0, 1), a2 + hstep, voffA);
            PG8_WAIT_L(8); PG8_BAR; PG8_WAIT_L(0); PG8_MMA(0, 0, At, B0); PG8_BAR; PG8_SCHED;
            PG8_LDB(B1, 1, 1); PG8_STAGE(PG8_SB(1, 0), b3, voffB);
            PG8_BAR; PG8_WAIT_L(0); PG8_MMA(0, 1, At, B1); PG8_BAR;
            PG8_LDA(At, 1, 1); PG8_STAGE(PG8_SA(1, 0), a3, voffA);
            PG8_BAR; PG8_WAIT_L(0); PG8_MMA(1, 0, At, B0); PG8_BAR; PG8_SCHED;
            PG8_STAGE(PG8_SB(1, 1), b3 + hstep, voffB);
            PG8_WAIT_V(6); PG8_BAR; PG8_MMA(1, 1, At, B1); PG8_BAR;
            }
        }
        if constexpr (ALIGN_EPI) { if (wr == 0) PG8_BAR; }
        if constexpr (!Epi::AFTER_DRAIN) { E(acc, cur, wr, wc, fr, fq); S.done(cur); }
        if (!has_next) break;
#pragma unroll
        for (int a = 0; a < 2; ++a)
#pragma unroll
            for (int b = 0; b < 2; ++b)
#pragma unroll
                for (int m = 0; m < 4; ++m)
#pragma unroll
                    for (int n = 0; n < 2; ++n) acc[a][b][m][n] = (f32x4){0.f, 0.f, 0.f, 0.f};
        cur = nxt; cA = nA; cB = nB; ++ui;
        if constexpr (ALIGN_EPI) { if (wr == 1) PG8_BAR; }
    }
    PG8_WAIT_V(0);
    if constexpr (!ALIGN_EPI) { if (wr == 0) PG8_BAR; }
    PG8_BAR;
    if constexpr (Epi::AFTER_DRAIN) { E.fused(acc, cur, wr, wc, fr, fq, lds, wid, lane); S.done(cur); }
#undef PG8_SA
#undef PG8_SB
#undef PG8_STAGE
#undef PG8_LDA
#undef PG8_LDB
#undef PG8_MMA
#undef PG8_WAIT_V
#undef PG8_WAIT_L
#undef PG8_BAR
#undef PG8_SCHED
}
}
#define GAS __attribute__((address_space(1)))
#define LAS __attribute__((address_space(3)))
typedef unsigned short bf16;
typedef unsigned v4u __attribute__((ext_vector_type(4)));
typedef float f32x4 __attribute__((ext_vector_type(4)));
typedef short bf16x8 __attribute__((ext_vector_type(8)));
typedef GAS unsigned gu32;
typedef GAS unsigned long long gu64;
#define RLX_AGENT __ATOMIC_RELAXED, __HIP_MEMORY_SCOPE_AGENT
#define LDS_WAIT() asm volatile("s_waitcnt lgkmcnt(0)" ::: "memory")
#define VM_WAIT() asm volatile("s_waitcnt vmcnt(0)" ::: "memory")
__device__ __forceinline__ unsigned long long rt() { return __builtin_amdgcn_s_memrealtime(); }
__device__ __forceinline__ unsigned f2bf(float f) { unsigned u = __builtin_bit_cast(unsigned, f); return (u + 0x7fffu + ((u >> 16) & 1u)) >> 16; }
__device__ __forceinline__ unsigned pk2(float lo, float hi) { return f2bf(lo) | (f2bf(hi) << 16); }

#define XB_TMO      128
#define XB_XCNT(j)  (256  + 64 * (j))
#define XB_XSUB(j)  (1280 + 64 * (j))
#define XB_XGEN(j)  (2304 + 64 * (j))
#define XB_TOP      3328
#define XB_TOPGEN   3392
#define XCD_BAR_WORDS 3456
#define XB_SPIN_CAP (1u << 18)

__device__ __forceinline__ unsigned xb_ld(unsigned* p)              { return __hip_atomic_load(p, __ATOMIC_RELAXED, __HIP_MEMORY_SCOPE_AGENT); }
__device__ __forceinline__ unsigned xb_add(unsigned* p, unsigned v) { return __hip_atomic_fetch_add(p, v, __ATOMIC_RELAXED, __HIP_MEMORY_SCOPE_AGENT); }
__device__ __forceinline__ unsigned xb_xcc_id() { return (unsigned)__builtin_amdgcn_s_getreg((3 << 11) | 20) & 0xFu; }
#define XB_SPIN(cond, bar) do { unsigned _sp = 0; while (cond) { __builtin_amdgcn_s_sleep(1); \
    if ((++_sp & 255u) == 0u) { if (xb_ld(&(bar)[XB_TMO])) break; if (_sp > XB_SPIN_CAP) { atomicAdd(&(bar)[XB_TMO], 1u); break; } } } } while (0)

struct XcdBarrier {
    unsigned* bar; unsigned x;
    volatile LAS unsigned* st;
};

__device__ __forceinline__ XcdBarrier xcd_barrier_post(unsigned* bar, volatile LAS unsigned* st) {
    XcdBarrier b; b.bar = bar; b.x = xb_xcc_id(); b.st = st;
    if (threadIdx.x == 0) (void)xb_add(&bar[XB_XCNT(b.x)], 1u);
    return b;
}
__device__ __forceinline__ void xcd_barrier_complete(unsigned* bar, unsigned x, unsigned& nloc, unsigned& nx) {
    const unsigned G = gridDim.x * gridDim.y * gridDim.z;
    unsigned sum, cnt, mine, sp = 0u;
    for (;;) {
        sum = 0u; cnt = 0u; mine = 0u;
#pragma unroll
        for (unsigned j = 0; j < 16; ++j) { const unsigned c = xb_ld(&bar[XB_XCNT(j)]); sum += c; cnt += (c > 0u) ? 1u : 0u; mine = (j == x) ? c : mine; }
        if (sum == G) break;
        __builtin_amdgcn_s_sleep(1);
        if ((++sp & 255u) == 0u) { if (xb_ld(&bar[XB_TMO])) break; if (sp > XB_SPIN_CAP) { atomicAdd(&bar[XB_TMO], 1u); break; } }
    }
    nloc = mine > 0u ? mine : 1u; nx = cnt > 0u ? cnt : 1u;
}

__device__ __forceinline__ void xcd_barrier(const XcdBarrier& b) {
    asm volatile("s_waitcnt vmcnt(0)" ::: "memory");
    __syncthreads();
    if (threadIdx.x == 0) {
        unsigned* bar = b.bar;
        __builtin_amdgcn_s_waitcnt(0);
        unsigned nloc = b.st[0], nx = b.st[1];
        if (nloc == 0u) { xcd_barrier_complete(bar, b.x, nloc, nx); b.st[0] = nloc; b.st[1] = nx; }
        const unsigned old = xb_add(&bar[XB_XSUB(b.x)], 1u);
        const unsigned gen = old / nloc;
        if (old + 1u == (gen + 1u) * nloc) {
            __builtin_amdgcn_fence(__ATOMIC_RELEASE, "agent");
            asm volatile("s_waitcnt vmcnt(0)" ::: "memory");
            const unsigned og = xb_add(&bar[XB_TOP], 1u);
            const unsigned tg = og / nx;
            if (og + 1u == (tg + 1u) * nx) xb_add(&bar[XB_TOPGEN], 1u);
            else XB_SPIN(xb_ld(&bar[XB_TOPGEN]) == tg, bar);
            __builtin_amdgcn_fence(__ATOMIC_ACQUIRE, "agent");
            xb_add(&bar[XB_XGEN(b.x)], 1u);
            asm volatile("s_waitcnt vmcnt(0)" ::: "memory");
        } else {
            XB_SPIN(xb_ld(&bar[XB_XGEN(b.x)]) == gen, bar);
            __builtin_amdgcn_fence(__ATOMIC_ACQUIRE, "agent");
            asm volatile("s_waitcnt vmcnt(0)" ::: "memory");
        }
    }
    __syncthreads();
}

constexpr int NWAVES = 8;
#ifndef USE_FA_SB
#define USE_FA_SB 1
#endif
#ifndef USE_FA_DIL
#define USE_FA_DIL 1
#endif
#ifndef USE_FA_NSA
#define USE_FA_NSA 1
#endif
#ifndef PROBE_SEC
#define PROBE_SEC 0
#endif
#ifndef PROBE_C
#define PROBE_C 1000
#endif
#ifndef PROBE_BR
#define PROBE_BR 0
#endif
#define PBR(k) ((PROBE_BR == 0 || PROBE_BR == (k)) ? 1.0f : 0.0f)
#ifndef REP_PHASE
#define REP_PHASE -1
#endif
#define NREP(k) ((REP_PHASE == (k)) ? 2 : 1)
#ifndef PROBE_T
#define PROBE_T 0
#endif
#define PROBE_T0 0
#define PROBE_T1 1
#ifndef PROBE_K
#define PROBE_K 10
#endif
#define TS_BASE 100000
#define TSTAMP() do { if (PROBE_T) { if (threadIdx.x == 0) { const unsigned long long now_ = wall_clock64(); unsigned long long* tsb_ = (unsigned long long*)(rd_ptr(F, PT_WS)) + TS_BASE; \
        const unsigned long long prev_ = ((unsigned long long)F.MISC[49] << 32) | F.MISC[48]; const unsigned idx_ = F.MISC[50]; const unsigned long long d_ = now_ - prev_; \
        if (PROBE_T > 100 && PROBE_T != 999) atomicMax(tsb_ + 256 + idx_, d_); else atomicAdd(tsb_ + idx_, d_); F.MISC[48] = (unsigned)now_; F.MISC[49] = (unsigned)(now_ >> 32); F.MISC[50] = idx_ + 1u; } } } while (0)
#ifndef PROBE_N
#define PROBE_N 0
#endif
#ifndef NSA_REP_A
#define NSA_REP_A 1
#endif
#ifndef NSA_REP_B
#define NSA_REP_B 1
#endif
#ifndef NSA_REP_C
#define NSA_REP_C 1
#endif
#ifndef SPLIT_INPROJ
#define SPLIT_INPROJ 1
#endif
#ifndef DEFER_CONV
#define DEFER_CONV 1
#endif
#ifndef MK_ONE_LAUNCH
#define MK_ONE_LAUNCH 1
#endif
constexpr int BATCH = 2, SEQ = 4096, MTOK = BATCH * SEQ, DM = 4096, HD = 128, DFF = 16384, DEPTH = 2;
constexpr int NSRC = 10788, NP = 11008;
constexpr float RMS_EPS = 1e-6f;
constexpr int C_NQ = 0, C_KC = 1536, C_KS = 1792, C_KW = 2048, C_DQ = 2304, C_DK = 3840, C_VC = 5376, C_VS = 5632, C_VW = 5888, C_DV = 6144, C_SQ = 7680, C_SK = 8704, C_SV = 9728, C_GT = 10752;
constexpr size_t MiB = 1u << 20;
constexpr size_t WS_CTL = 0, CTL_ZERO_BYTES = 1 * MiB;
constexpr size_t WS_COS = 1 * MiB, WS_SIN = 2 * MiB, WS_KC = 3 * MiB, WS_KCB = 3 * MiB + 512 * 1024, WS_SEL = 4 * MiB, WS_LSE = 5 * MiB, WS_SS = 300 * 1024  , WS_PEP = 900 * 1024  , WS_W1T = 1488 * MiB  ;
constexpr size_t WS_WIN = 8 * MiB, WIN_L = (size_t)NP * DM * 2;
constexpr size_t WS_WOUT = 180 * MiB, WOUT_L = (size_t)DM * DM * 2;
constexpr size_t WS_WUP = 244 * MiB, WUP_L = (size_t)DFF * DM * 2;
constexpr size_t WS_WDN = 500 * MiB, WDN_L = (size_t)DM * DFF * 2;
constexpr size_t WS_H = 756 * MiB, WS_PROJ = 820 * MiB, WS_OCAT = 992 * MiB, WS_X = 1056 * MiB, WS_U = 1184 * MiB, WS_OCMP = 1440 * MiB, WS_KVC = 1504 * MiB  , WS_END = 1520 * MiB;
static_assert(WS_WIN + 2 * WIN_L <= WS_WOUT && WS_PROJ + (size_t)MTOK * NP * 2 <= WS_OCAT, "ws map");
constexpr int CW_TMO = 0, CW_CODE = 1, CW_BAR = 4096;
constexpr int NPH = 1 + 9 * DEPTH;
static_assert((CW_BAR + NPH * 3456) * 4 <= (int)CTL_ZERO_BYTES, "ctl");
constexpr int MISC_OFF = 0, RING_OFF = 1024, RING_BYTES = 131072, LDS_BYTES = 147456;

struct Frame {
    LAS unsigned char* lds; volatile LAS unsigned* MISC;
    int wave;
};
struct Ctx { LAS unsigned char* lds; int wave, lane, tid, G, bid, gw, ngw; };
#define CTX() Ctx C; do { int w_ = F.wave, g_ = (int)gridDim.x, b_ = (int)blockIdx.x; asm volatile("" : "+s"(w_), "+s"(g_), "+s"(b_)); C.lds = F.lds; C.wave = w_; C.G = g_; C.bid = b_; \
    C.gw = b_ * NWAVES + w_; C.ngw = g_ * NWAVES; C.lane = fresh_lane(); C.tid = w_ * 64 + C.lane; } while (0)
__device__ __forceinline__ int fresh_lane() { int l = (int)__builtin_amdgcn_mbcnt_hi(~0u, __builtin_amdgcn_mbcnt_lo(~0u, 0u)); asm volatile("" : "+v"(l)); return l; }
constexpr int PT_OUT = 14, PT_WS = 15;
__device__ __forceinline__ unsigned long long rd_ptr(const Frame& F, int k) {
    const unsigned lo = F.MISC[16 + 2 * k], hi = F.MISC[17 + 2 * k];
    return ((unsigned long long)(unsigned)__builtin_amdgcn_readfirstlane((int)hi) << 32) | (unsigned)__builtin_amdgcn_readfirstlane((int)lo);
}
#define PIN(k) ((const float*)rd_ptr(F, (k)))
#define PWS(T, off) ((T*)(rd_ptr(F, PT_WS) + (off)))
__device__ __forceinline__ float wave_sum(float v) {
#pragma unroll
    for (int o = 1; o < 64; o <<= 1) v += __shfl_xor(v, o);
    return v;
}
__device__ __forceinline__ float wave_max(float v) {
#pragma unroll
    for (int o = 1; o < 64; o <<= 1) v = fmaxf(v, __shfl_xor(v, o));
    return v;
}
__device__ __forceinline__ float bf2f(bf16 v) { return __uint_as_float((unsigned)v << 16); }
__device__ __forceinline__ float blo(unsigned w) { return __uint_as_float(w << 16); }
__device__ __forceinline__ float bhi(unsigned w) { return __uint_as_float(w & 0xffff0000u); }
__device__ __forceinline__ float ex2(float x) { return __builtin_amdgcn_exp2f(x); }
__device__ __forceinline__ float lg2(float x) { return __builtin_amdgcn_logf(x); }

__device__ __forceinline__ int il128(int d) { return ((d & 63) >> 2) * 8 + (d >> 6) * 4 + (d & 3); }
__device__ __forceinline__ int win_dest(int c) {
    if (c < 1536) return C_NQ + (c & ~127) + il128(c & 127);
    if (c < 3072) { const int e = c - 1536, seg = e >> 8, w = e & 255;
        const int base = seg == 0 ? C_KC : seg == 1 ? C_VC : seg == 2 ? C_KS : seg == 3 ? C_VS : seg == 4 ? C_KW : C_VW;
        return base + (w & ~127) + ((seg & 1) ? (w & 127) : il128(w & 127)); }
    if (c < 3108) return C_GT + (c - 3072);
    if (c < 4644) { const int e = c - 3108; return C_DQ + (e & ~127) + il128(e & 127); }
    if (c < 6180) { const int e = c - 4644; return C_DK + (e & ~127) + il128(e & 127); }
    if (c < 7716) return C_DV + (c - 6180);
    if (c < 8740) return C_SQ + (c - 7716);
    if (c < 9764) return C_SK + (c - 8740);
    return C_SV + (c - 9764);
}
template <bool MAPPED, bool PEDOT = false>
__device__ __forceinline__ void transpose_item(const float* W, int K, int N, bf16* WT, int kb, int nb, int lane, const float* pe = nullptr, float* pesum = nullptr, const float* gain = nullptr) {
    const int kr = lane >> 4, nq = lane & 15, k0 = 64 * kb + 16 * kr, n = 64 * nb + 4 * nq; const bool ok = n < N;
    const float* src = W + (size_t)k0 * N + (ok ? n : 0);
    f32x4 v[16];
#pragma unroll
    for (int i = 0; i < 16; ++i) v[i] = __builtin_nontemporal_load((const f32x4*)(src + (size_t)i * N));
    if (gain) {
#pragma unroll
        for (int i4 = 0; i4 < 4; ++i4) { const f32x4 g4 = *(const f32x4*)(gain + k0 + 4 * i4);
#pragma unroll
            for (int e = 0; e < 4; ++e) v[4 * i4 + e] *= g4[e]; } }
    if (ok) {
#pragma unroll
        for (int j = 0; j < 4; ++j) { const int dr = MAPPED ? win_dest(n + j) : n + j; v4u lo, hi;
            lo.x = pg8::cvt_pk_bf16(v[0][j], v[1][j]); lo.y = pg8::cvt_pk_bf16(v[2][j], v[3][j]); lo.z = pg8::cvt_pk_bf16(v[4][j], v[5][j]); lo.w = pg8::cvt_pk_bf16(v[6][j], v[7][j]);
            hi.x = pg8::cvt_pk_bf16(v[8][j], v[9][j]); hi.y = pg8::cvt_pk_bf16(v[10][j], v[11][j]); hi.z = pg8::cvt_pk_bf16(v[12][j], v[13][j]); hi.w = pg8::cvt_pk_bf16(v[14][j], v[15][j]);
            v4u* dst = (v4u*)(WT + (size_t)dr * K + k0); dst[0] = lo; dst[1] = hi; } }
    if (PEDOT) {
        f32x4 s = {0.f, 0.f, 0.f, 0.f};
#pragma unroll
        for (int i = 0; i < 16; ++i) s += pe[k0 + i] * v[i];
#pragma unroll
        for (int j = 0; j < 4; ++j) { float t = s[j]; t += __shfl_xor(t, 16); t += __shfl_xor(t, 32); if (kr == 0 && ok) fx_add(pesum + 2 * (n + j), t, FX_KC); } }
}
struct TrItem { const float* src; size_t N; const float* gain; bf16* WT; int K, k0, n; bool ok, mapped; };
__device__ __forceinline__ TrItem tr_make(const float* W, int K, int N, bf16* WT, int kb, int nb, int lane, const float* gain, bool mapped) {
    const int kr = lane >> 4, nq = lane & 15, k0 = 64 * kb + 16 * kr, n = 64 * nb + 4 * nq; const bool ok = n < N;
    TrItem t; t.src = W + (size_t)k0 * N + (ok ? n : 0); t.N = (size_t)N; t.gain = gain; t.WT = WT; t.K = K; t.k0 = k0; t.n = n; t.ok = ok; t.mapped = mapped; return t;
}
__device__ __forceinline__ void tr_load(f32x4 (&v)[16], const TrItem& t) {
#pragma unroll
    for (int i = 0; i < 16; ++i) v[i] = __builtin_nontemporal_load((const f32x4*)(t.src + (size_t)i * t.N));
}
__device__ __forceinline__ void tr_store(f32x4 (&v)[16], const TrItem& t) {
    if (t.gain) {
#pragma unroll
        for (int i4 = 0; i4 < 4; ++i4) { const f32x4 g4 = *(const f32x4*)(t.gain + t.k0 + 4 * i4);
#pragma unroll
            for (int e = 0; e < 4; ++e) v[4 * i4 + e] *= g4[e]; } }
    if (t.ok) {
#pragma unroll
        for (int j = 0; j < 4; ++j) { const int dr = t.mapped ? win_dest(t.n + j) : t.n + j; v4u lo, hi;
            lo.x = pg8::cvt_pk_bf16(v[0][j], v[1][j]); lo.y = pg8::cvt_pk_bf16(v[2][j], v[3][j]); lo.z = pg8::cvt_pk_bf16(v[4][j], v[5][j]); lo.w = pg8::cvt_pk_bf16(v[6][j], v[7][j]);
            hi.x = pg8::cvt_pk_bf16(v[8][j], v[9][j]); hi.y = pg8::cvt_pk_bf16(v[10][j], v[11][j]); hi.z = pg8::cvt_pk_bf16(v[12][j], v[13][j]); hi.w = pg8::cvt_pk_bf16(v[14][j], v[15][j]);
            v4u* dst = (v4u*)(t.WT + (size_t)dr * t.K + t.k0); dst[0] = lo; dst[1] = hi; } }
}
__device__ __forceinline__ void sincos_red(double x, double& s, double& c) {
    const double kd = rint(x * 0.63661977236758134308);
    double r = fma(-kd, 1.57079632679489655800e+00, x); r = fma(-kd, 6.12323399573676603587e-17, r);
    const int q = ((int)kd) & 3; const double r2 = r * r;
    const double sp = r * (1.0 + r2 * (-1.0 / 6 + r2 * (1.0 / 120 + r2 * (-1.0 / 5040 + r2 * (1.0 / 362880 + r2 * (-1.0 / 39916800 + r2 * (1.0 / 6227020800.0)))))));
    const double cp = 1.0 + r2 * (-0.5 + r2 * (1.0 / 24 + r2 * (-1.0 / 720 + r2 * (1.0 / 40320 + r2 * (-1.0 / 3628800 + r2 * (1.0 / 479001600.0 + r2 * (-1.0 / 87178291200.0)))))));
    s = (q == 0) ? sp : (q == 1) ? cp : (q == 2) ? -sp : -cp;
    c = (q == 0) ? cp : (q == 1) ? -sp : (q == 2) ? -cp : sp;
}
__device__ __forceinline__ void rms_row(const float* xrow, const float* g, bf16* ob, float* of, int lane) {
    const f32x4* xr = (const f32x4*)xrow + lane; f32x4 v[16]; float s = 0.f;
#pragma unroll
    for (int j = 0; j < 16; ++j) { v[j] = xr[64 * j]; s += (v[j].x * v[j].x + v[j].y * v[j].y) + (v[j].z * v[j].z + v[j].w * v[j].w); }
    const float rstd = 1.0f / sqrtf(wave_sum(s) * (1.0f / DM) + RMS_EPS);
    const f32x4* gr = (const f32x4*)g + lane;
#pragma unroll
    for (int j = 0; j < 16; ++j) { const f32x4 gv = gr[64 * j]; const f32x4 y = v[j] * rstd * gv;
        if (ob) ((unsigned long long*)ob)[lane + 64 * j] = (unsigned long long)pk2(y.x, y.y) | ((unsigned long long)pk2(y.z, y.w) << 32);
        else ((f32x4*)of)[lane + 64 * j] = y; }
}
__device__ __forceinline__ void raw_phase(const Ctx& C, const float* xin, bf16* ob, float* ss) {
    const int lane = C.lane;
    for (int m = C.gw; m < MTOK; m += C.ngw) { const f32x4* xr = (const f32x4*)(xin + (size_t)m * DM) + lane; float s = 0.f;
#pragma unroll
        for (int j = 0; j < 16; ++j) { const f32x4 v = __builtin_nontemporal_load(xr + 64 * j);     s += (v.x * v.x + v.y * v.y) + (v.z * v.z + v.w * v.w);
            ((unsigned long long*)(ob + (size_t)m * DM))[lane + 64 * j] = (unsigned long long)pg8::cvt_pk_bf16(v.x, v.y) | ((unsigned long long)pg8::cvt_pk_bf16(v.z, v.w) << 32); }
        s = wave_sum(s); if (lane == 0) fx_put(ss + 2 * m, s, FX_SS); }
}
__device__ __forceinline__ void norm_phase_b(const Ctx& C, const bf16* xin, const float* g, float* of) {
    const int lane = C.lane;
    for (int m = C.gw; m < MTOK; m += C.ngw) { const v4u* xr = (const v4u*)(xin + (size_t)m * DM) + lane; f32x4 y[16]; float s = 0.f;
#pragma unroll
        for (int j = 0; j < 8; ++j) { const v4u a = __builtin_nontemporal_load(xr + 64 * j);
            y[2 * j] = (f32x4){__uint_as_float(a.x << 16), __uint_as_float(a.x & 0xffff0000u), __uint_as_float(a.y << 16), __uint_as_float(a.y & 0xffff0000u)};
            y[2 * j + 1] = (f32x4){__uint_as_float(a.z << 16), __uint_as_float(a.z & 0xffff0000u), __uint_as_float(a.w << 16), __uint_as_float(a.w & 0xffff0000u)};
            s += ((y[2 * j].x * y[2 * j].x + y[2 * j].y * y[2 * j].y) + (y[2 * j].z * y[2 * j].z + y[2 * j].w * y[2 * j].w)) + ((y[2 * j + 1].x * y[2 * j + 1].x + y[2 * j + 1].y * y[2 * j + 1].y) + (y[2 * j + 1].z * y[2 * j + 1].z + y[2 * j + 1].w * y[2 * j + 1].w)); }
        const float rstd = 1.0f / sqrtf(wave_sum(s) * (1.0f / DM) + RMS_EPS);
        const f32x4* gr = (const f32x4*)g + 2 * lane; f32x4* orow = (f32x4*)(of + (size_t)m * DM) + 2 * lane;
#pragma unroll
        for (int j = 0; j < 8; ++j) { orow[128 * j] = y[2 * j] * rstd * gr[128 * j]; orow[128 * j + 1] = y[2 * j + 1] * rstd * gr[128 * j + 1]; } }
}
__device__ __forceinline__ void norm_phase(const Ctx& C, const float* xin, const float* g, bf16* ob, float* of) {
    const int lane = C.lane;
    for (int m = C.gw; m < MTOK; m += C.ngw) rms_row(xin + (size_t)m * DM, g, ob ? ob + (size_t)m * DM : nullptr, of ? of + (size_t)m * DM : nullptr, lane);
}

namespace fa {
typedef float f32x16 __attribute__((ext_vector_type(16)));
typedef short s16x4 __attribute__((ext_vector_type(4)));
typedef short bx8 __attribute__((ext_vector_type(8)));
typedef unsigned u32x4 __attribute__((ext_vector_type(4)));
typedef unsigned u32x2 __attribute__((ext_vector_type(2)));
constexpr int SHM_T = 16384;
constexpr int L_V = 0, L_K = 2 * SHM_T, L_WS = 4 * SHM_T;
constexpr int LDS_NEED = L_WS + 8192;
#define FA_KSWZ(row, colB) ((row) * 256 + ((colB) ^ (((row) & 15) << 4)))
__device__ __forceinline__ int v_st(int k, int c) { const int kk = (k & ~0xC) | ((k & 4) << 1) | ((k & 8) >> 1); return ((kk >> 3) * 4 + (c >> 5)) * 512 + ((kk & 7) * 32 + (c & 31)) * 2; }
__device__ __forceinline__ int v_rd_base(int lane) { return ((lane & 3) << 3) | (((lane >> 2) & 3) << 6) | (((lane >> 4) & 1) << 5) | (((lane >> 5) & 1) << 8); }
__device__ __forceinline__ int crow(int r, int hi) { return (r & 3) + 8 * (r >> 2) + 4 * hi; }
__device__ __forceinline__ unsigned cvtpk(float lo, float hi) { unsigned r; asm volatile("v_cvt_pk_bf16_f32 %0, %1, %2" : "=v"(r) : "v"(lo), "v"(hi)); return r; }
__device__ __forceinline__ float fadd_s(float a, float b) { float r; asm("v_add_f32 %0, %1, %2" : "=v"(r) : "v"(a), "v"(b)); return r; }
__device__ __forceinline__ float swap_max(float v) { auto rr = __builtin_amdgcn_permlane32_swap(__float_as_uint(v), __float_as_uint(v), false, false); return fmaxf(__uint_as_float(rr[0]), __uint_as_float(rr[1])); }
__device__ __forceinline__ float swap_sum(float v) { auto rr = __builtin_amdgcn_permlane32_swap(__float_as_uint(v), __float_as_uint(v), false, false); return __uint_as_float(rr[0]) + __uint_as_float(rr[1]); }
#define FA_PK4(P, B_, OUT) do { const unsigned a0_ = fa::cvtpk(P[B_ + 0], P[B_ + 1]), a1_ = fa::cvtpk(P[B_ + 2], P[B_ + 3]), b0_ = fa::cvtpk(P[B_ + 4], P[B_ + 5]), b1_ = fa::cvtpk(P[B_ + 6], P[B_ + 7]); \
        auto r0_ = __builtin_amdgcn_permlane32_swap(a0_, b0_, false, false); auto r1_ = __builtin_amdgcn_permlane32_swap(a1_, b1_, false, false); \
        fa::u32x4 w_ = {r0_[0], r1_[0], r0_[1], r1_[1]}; OUT = __builtin_bit_cast(fa::bx8, w_); } while (0)
struct Ids { int wid, lane, r32, hi, sr, sc, kws, vst0, vst1; };
__device__ __forceinline__ Ids make_ids(int wid, int lane) { Ids I; I.wid = wid; I.lane = lane; I.r32 = lane & 31; I.hi = lane >> 5; const int tid = wid * 64 + lane; I.sr = tid >> 4; I.sc = (tid & 15) * 8;
    I.kws = FA_KSWZ(I.sr, I.sc * 2); I.vst0 = v_st(I.sr, I.sc); I.vst1 = v_st(32 + I.sr, I.sc); return I; }
#define FA_G(T, p) ((const GAS T*)(p))
#define FA_GW(T, p) ((GAS T*)(p))
__device__ __forceinline__ Ids make_ids_op(int wid, int lane) { asm volatile("" : "+v"(lane)); return make_ids(wid, lane); }
struct Stage { bx8 k0, k1, v0, v1; };
__device__ __forceinline__ void stage_load(Stage& s, const bf16* Kt, const bf16* Vt, long pitch, const Ids& I) {
    s.v0 = *FA_G(bx8, Vt + (long)I.sr * pitch + I.sc); s.v1 = *FA_G(bx8, Vt + (long)(32 + I.sr) * pitch + I.sc);
    s.k0 = *FA_G(bx8, Kt + (long)I.sr * pitch + I.sc); s.k1 = *FA_G(bx8, Kt + (long)(32 + I.sr) * pitch + I.sc);
}
__device__ __forceinline__ void stage_write(const Stage& s, LAS unsigned char* lds, int buf, const Ids& I) {
    *(LAS bx8*)(lds + L_K + buf * SHM_T + I.kws) = s.k0; *(LAS bx8*)(lds + L_K + buf * SHM_T + I.kws + 32 * 256) = s.k1;
    *(LAS bx8*)(lds + L_V + buf * SHM_T + I.vst0) = s.v0; *(LAS bx8*)(lds + L_V + buf * SHM_T + I.vst1) = s.v1;
}
__device__ __forceinline__ void load_q(bx8 (&qr)[8], const bf16* qrow, int hi) {
#pragma unroll
    for (int d0 = 0; d0 < 8; ++d0) qr[d0] = *FA_G(bx8, qrow + d0 * 16 + hi * 8);
}
__device__ __forceinline__ void qkt(f32x16& p0, f32x16& p1, LAS const unsigned char* lds, int buf, const Ids& I, const bx8 (&qr)[8]) {
    p0 = f32x16{}; p1 = f32x16{};
    unsigned kb0 = (unsigned)(size_t)(lds + L_K + buf * SHM_T) + FA_KSWZ(I.r32, I.hi * 16); asm volatile("" : "+v"(kb0));
    const unsigned k0 = kb0, k1 = kb0 ^ 32u, k2 = kb0 ^ 64u, k3 = kb0 ^ 96u, k4 = kb0 ^ 128u, k5 = kb0 ^ 160u, k6 = kb0 ^ 192u, k7 = kb0 ^ 224u;
#define FA_KRD(dst, a, off) asm volatile("ds_read_b128 %0, %1 offset:%2" : "=&v"(dst) : "v"(a), "i"(off) : "memory")
#define FA_KW(n) do { asm volatile("s_waitcnt lgkmcnt(" #n ")" ::: "memory"); __builtin_amdgcn_sched_barrier(0); } while (0)
#define FA_KM(x0, x1, d0) do { p0 = __builtin_amdgcn_mfma_f32_32x32x16_bf16(x0, qr[d0], p0, 0, 0, 0); p1 = __builtin_amdgcn_mfma_f32_32x32x16_bf16(x1, qr[d0], p1, 0, 0, 0); } while (0)
    bx8 a0, a1, b0, b1, c0, c1;
    __builtin_amdgcn_sched_barrier(0);
    FA_KRD(a0, k0, 0); FA_KRD(a1, k0, 8192); FA_KRD(b0, k1, 0); FA_KRD(b1, k1, 8192); FA_KRD(c0, k2, 0); FA_KRD(c1, k2, 8192);
    FA_KW(4); FA_KM(a0, a1, 0); FA_KRD(a0, k3, 0);   FA_KRD(a1, k3, 8192);
    FA_KW(4); FA_KM(b0, b1, 1); FA_KRD(b0, k4, 0); FA_KRD(b1, k4, 8192);
    FA_KW(4); FA_KM(c0, c1, 2); FA_KRD(c0, k5, 0); FA_KRD(c1, k5, 8192);
    FA_KW(4); FA_KM(a0, a1, 3); FA_KRD(a0, k6, 0); FA_KRD(a1, k6, 8192);
    FA_KW(4); FA_KM(b0, b1, 4); FA_KRD(b0, k7, 0); FA_KRD(b1, k7, 8192);
    FA_KW(4); FA_KM(c0, c1, 5);
    FA_KW(2); FA_KM(a0, a1, 6);
    FA_KW(0); FA_KM(b0, b1, 7);
#undef FA_KM
#undef FA_KW
#undef FA_KRD
}
__device__ __forceinline__ void pvT(f32x16 (&o)[4], LAS const unsigned char* lds, int buf, const Ids& I, bx8 pa0, bx8 pa1, bx8 pa2, bx8 pa3) {
    const unsigned va = (unsigned)(size_t)(lds + L_V + buf * SHM_T) + (unsigned)v_rd_base(I.lane);
#define FA_TRRD(dst, off) asm volatile("ds_read_b64_tr_b16 %0, %1 offset:%2" : "=&v"(dst) : "v"(va), "i"(off) : "memory")
#define FA_PV(d0) do { s16x4 l0, l1, l2, l3, h0, h1, h2, h3; constexpr int b_ = (d0) * 512; \
        FA_TRRD(l0, b_); FA_TRRD(h0, b_ + 2048); FA_TRRD(l1, b_ + 4096); FA_TRRD(h1, b_ + 6144); FA_TRRD(l2, b_ + 8192); FA_TRRD(h2, b_ + 10240); FA_TRRD(l3, b_ + 12288); FA_TRRD(h3, b_ + 14336); \
        asm volatile("s_waitcnt lgkmcnt(0)" ::: "memory"); __builtin_amdgcn_sched_barrier(0); \
        o[d0] = __builtin_amdgcn_mfma_f32_32x32x16_bf16((bx8){l0[0], l0[1], l0[2], l0[3], h0[0], h0[1], h0[2], h0[3]}, pa0, o[d0], 0, 0, 0); \
        o[d0] = __builtin_amdgcn_mfma_f32_32x32x16_bf16((bx8){l1[0], l1[1], l1[2], l1[3], h1[0], h1[1], h1[2], h1[3]}, pa1, o[d0], 0, 0, 0); \
        o[d0] = __builtin_amdgcn_mfma_f32_32x32x16_bf16((bx8){l2[0], l2[1], l2[2], l2[3], h2[0], h2[1], h2[2], h2[3]}, pa2, o[d0], 0, 0, 0); \
        o[d0] = __builtin_amdgcn_mfma_f32_32x32x16_bf16((bx8){l3[0], l3[1], l3[2], l3[3], h3[0], h3[1], h3[2], h3[3]}, pa3, o[d0], 0, 0, 0); } while (0)
    FA_PV(0); FA_PV(1); FA_PV(2); FA_PV(3);
#undef FA_PV
#undef FA_TRRD
}
__device__ __forceinline__ void store_oT(const f32x16 (&o)[4], float scale, bf16* orow, int hi) {
#pragma unroll
    for (int d0 = 0; d0 < 4; ++d0)
#pragma unroll
        for (int g4 = 0; g4 < 4; ++g4) { u32x2 w; w.x = cvtpk(o[d0][4 * g4] * scale, o[d0][4 * g4 + 1] * scale); w.y = cvtpk(o[d0][4 * g4 + 2] * scale, o[d0][4 * g4 + 3] * scale);
            *FA_GW(u32x2, orow + 32 * d0 + 8 * g4 + 4 * hi) = w; }
}

__device__ __forceinline__ void sb_unit(const bf16* PROJ, bf16* OCAT, int b, int h, int t0, LAS unsigned char* lds, const Ids& I) {
    const int tq = t0 + I.wid * 32 + I.r32;
    const size_t row = (size_t)b * SEQ + tq;
    bx8 qr[8]; load_q(qr, PROJ + row * NP + C_SQ + h * 128, I.hi);
    const bf16* Kh = PROJ + (size_t)b * SEQ * NP + C_SK + h * 128; const bf16* Vh = PROJ + (size_t)b * SEQ * NP + C_SV + h * 128;
    bx8 T0, T1, ONES;
#pragma unroll
    for (int e = 0; e < 8; ++e) { T0[e] = (8 * I.hi + e > I.r32) ? (short)0x3F80 : (short)0; T1[e] = (16 + 8 * I.hi + e > I.r32) ? (short)0x3F80 : (short)0; ONES[e] = (short)0x3F80; }
    f32x16 o[4] = {f32x16{}, f32x16{}, f32x16{}, f32x16{}};
    float R = 0.f; bool dead = false;
    const int jt = (t0 >> 6) + 3, NT = jt + 1;
    LAS unsigned* flags = (LAS unsigned*)(lds + L_WS);
    Stage st; stage_load(st, Kh + (size_t)(jt * 64) * NP, Vh + (size_t)(jt * 64) * NP, NP, I);
    asm volatile("s_waitcnt vmcnt(0)" ::: "memory"); stage_write(st, lds, 0, I);
    if (NT > 1) stage_load(st, Kh + (size_t)(jt * 64 - 64) * NP, Vh + (size_t)(jt * 64 - 64) * NP, NP, I);
    __syncthreads();
    const int wfirst = t0 + I.wid * 32;
    for (int it = 0; it < NT; ++it) { const int j = jt - it, buf = it & 1, kb = j * 64;
        if (it + 1 < NT) { asm volatile("s_waitcnt vmcnt(0)" ::: "memory"); stage_write(st, lds, buf ^ 1, I); }
        if (it + 2 < NT) stage_load(st, Kh + (size_t)(kb - 128) * NP, Vh + (size_t)(kb - 128) * NP, NP, I);
        if (kb < wfirst + 31 && !dead) {
            f32x16 p0, p1; qkt(p0, p1, lds, buf, I, qr);
            const bool diag = kb + 63 >= wfirst;
            bx8 lm0, lm1, lm2, lm3; float l1first;
#define FA_SB_ELEM(P, B_, KOFF) _Pragma("unroll") for (int r = 0; r < 8; ++r) { const float z = P[B_ + r]; const float e = ex2(-fabsf(z)), lg = lg2(1.0f + e); float lb = fminf(z, 0.f) - lg, l1 = lb - z; \
                if (diag && (kb + KOFF + crow(B_ + r, I.hi) >= tq)) { lb = -__builtin_inff(); l1 = 0.f; } P[B_ + r] = lb; l1v[r] = l1; }
            { float l1v[8]; FA_SB_ELEM(p0, 0, 0); l1first = l1v[0]; FA_PK4(l1v, 0, lm0); }
            { float l1v[8]; FA_SB_ELEM(p0, 8, 0); FA_PK4(l1v, 0, lm1); }
            { float l1v[8]; FA_SB_ELEM(p1, 0, 32); FA_PK4(l1v, 0, lm2); }
            { float l1v[8]; FA_SB_ELEM(p1, 8, 32); FA_PK4(l1v, 0, lm3); }
#undef FA_SB_ELEM
            f32x16 s0 = f32x16{}, s1 = f32x16{};
            s0 = __builtin_amdgcn_mfma_f32_32x32x16_bf16(T0, lm0, s0, 0, 0, 0); s0 = __builtin_amdgcn_mfma_f32_32x32x16_bf16(T1, lm1, s0, 0, 0, 0);
            s0 = __builtin_amdgcn_mfma_f32_32x32x16_bf16(ONES, lm2, s0, 0, 0, 0); s0 = __builtin_amdgcn_mfma_f32_32x32x16_bf16(ONES, lm3, s0, 0, 0, 0);
            s1 = __builtin_amdgcn_mfma_f32_32x32x16_bf16(T0, lm2, s1, 0, 0, 0); s1 = __builtin_amdgcn_mfma_f32_32x32x16_bf16(T1, lm3, s1, 0, 0, 0);
            const float tot = __shfl(s0[0] + l1first, I.r32);
#pragma unroll
            for (int r = 0; r < 16; ++r) { p0[r] = ex2(p0[r] + R + s0[r]); p1[r] = ex2(p1[r] + R + s1[r]); }
            R += tot;
            bx8 pa0, pa1, pa2, pa3; FA_PK4(p0, 0, pa0); FA_PK4(p0, 8, pa1); FA_PK4(p1, 0, pa2); FA_PK4(p1, 8, pa3);
            pvT(o, lds, buf, I, pa0, pa1, pa2, pa3);
            dead = __all(R < -160.f) != 0;
        }
        if (I.lane == 0) flags[(it & 1) * 8 + I.wid] = dead ? 1u : 0u;
        __syncthreads();
        const u32x4 f0 = *(LAS const u32x4*)(flags + (it & 1) * 8), f1 = *(LAS const u32x4*)(flags + (it & 1) * 8 + 4);
        if ((f0.x & f0.y & f0.z & f0.w & f1.x & f1.y & f1.z & f1.w) != 0u) break;
    }
    store_oT(o, 1.0f, OCAT + row * DM + 3072 + h * 128, I.hi);
    __syncthreads();
}

template <bool SEL>
__device__ __forceinline__ void sm_tiles(f32x16 (&o)[4], float& m, float& l, const bx8 (&qr)[8], const bf16* Kh, const bf16* Vh, long pitch, int j_lo, int j_hi,
                                         int pq, int wfirst, unsigned W, unsigned long long selmask, LAS unsigned char* lds, const Ids& I) {
    const int NT = j_hi - j_lo + 1;
#define FA_KT(t) (Kh + (long)((j_lo + (t)) * 64) * pitch)
#define FA_VT(t) (Vh + (long)((j_lo + (t)) * 64) * pitch)
#define FA_ACT(t) ((((j_lo + (t)) * 64) <= wfirst + 31) && ((long)((j_lo + (t)) * 64) + 63 >= (long)wfirst - (long)(W - 1u)) && (!SEL || (__any((((selmask >> (j_lo + (t))) & 1ull) != 0ull) ? 1 : 0) != 0)))
    Stage st; { Stage s0; stage_load(s0, FA_KT(0), FA_VT(0), pitch, I);
        if (NT > 1) stage_load(st, FA_KT(1), FA_VT(1), pitch, I);
        asm volatile("s_waitcnt vmcnt(0)" ::: "memory"); stage_write(s0, lds, 0, I); }
    if (NT > 1) { *(LAS bx8*)(lds + L_K + SHM_T + I.kws) = st.k0; *(LAS bx8*)(lds + L_K + SHM_T + I.kws + 32 * 256) = st.k1; }
    if (NT > 2) { st.k0 = *FA_G(bx8, FA_KT(2) + (long)I.sr * pitch + I.sc); st.k1 = *FA_G(bx8, FA_KT(2) + (long)(32 + I.sr) * pitch + I.sc); }
    __syncthreads();
    f32x16 pA0, pA1, pB0, pB1; bool actA = FA_ACT(0), actB = false;
    if (actA) qkt(pA0, pA1, lds, 0, I, qr);
    __syncthreads();
#define FA_TRIP(PX0, PX1, actX, PY0, PY1, actY, it) do { const int j_ = j_lo + (it), buf_ = (it) & 1, kb_ = j_ * 64; \
        if ((it) + 1 < NT) { asm volatile("s_waitcnt vmcnt(0)" ::: "memory"); \
            *(LAS bx8*)(lds + L_V + (buf_ ^ 1) * SHM_T + I.vst0) = st.v0; *(LAS bx8*)(lds + L_V + (buf_ ^ 1) * SHM_T + I.vst1) = st.v1; \
            if ((it) + 2 < NT) { *(LAS bx8*)(lds + L_K + buf_ * SHM_T + I.kws) = st.k0; *(LAS bx8*)(lds + L_K + buf_ * SHM_T + I.kws + 32 * 256) = st.k1; } } \
        if ((it) + 2 < NT) { st.v0 = *FA_G(bx8, FA_VT((it) + 2) + (long)I.sr * pitch + I.sc); st.v1 = *FA_G(bx8, FA_VT((it) + 2) + (long)(32 + I.sr) * pitch + I.sc); } \
        if ((it) + 3 < NT) { st.k0 = *FA_G(bx8, FA_KT((it) + 3) + (long)I.sr * pitch + I.sc); st.k1 = *FA_G(bx8, FA_KT((it) + 3) + (long)(32 + I.sr) * pitch + I.sc); } \
        actY = ((it) + 1 < NT) && FA_ACT((it) + 1); \
        if (actY) qkt(PY0, PY1, lds, buf_ ^ 1, I, qr); \
        if (actX) { \
            const bool rsel_ = SEL ? (((selmask >> j_) & 1ull) != 0ull) : true; \
            const bool edge_ = (kb_ + 63 > wfirst) || ((long)kb_ < (long)wfirst + 31 - (long)(W - 1u)); \
            if (edge_) { const int dq_ = pq - kb_ - 4 * I.hi; const float NEG_ = -__builtin_inff(); \
                _Pragma("unroll") for (int r = 0; r < 16; ++r) { const int c_ = (r & 3) + 8 * (r >> 2); \
                    if ((unsigned)(dq_ - c_) >= W) PX0[r] = NEG_; if ((unsigned)(dq_ - c_ - 32) >= W) PX1[r] = NEG_; } } \
            float mx_ = PX0[0]; \
            _Pragma("unroll") for (int r = 1; r < 16; ++r) mx_ = fmaxf(mx_, PX0[r]); \
            _Pragma("unroll") for (int r = 0; r < 16; ++r) mx_ = fmaxf(mx_, PX1[r]); \
            mx_ = swap_max(mx_); if (SEL && !rsel_) mx_ = -__builtin_inff(); \
            if (__any(mx_ > m + 8.0f)) { const float mn_ = fmaxf(m, mx_), alpha_ = ex2(m - mn_); m = mn_; l *= alpha_; \
                _Pragma("unroll") for (int d0 = 0; d0 < 4; ++d0) _Pragma("unroll") for (int r = 0; r < 16; ++r) o[d0][r] *= alpha_; } \
            const float mref_ = (SEL && !rsel_) ? __builtin_inff() : m; float ps_ = 0.f; \
            PX0 = PX0 - mref_; PX1 = PX1 - mref_;     \
            _Pragma("unroll") for (int r = 0; r < 16; ++r) { PX0[r] = ex2(PX0[r]); PX1[r] = ex2(PX1[r]); } \
            { float s_[16];     \
              _Pragma("unroll") for (int r = 0; r < 16; ++r) s_[r] = fadd_s(PX0[r], PX1[r]); \
              _Pragma("unroll") for (int r = 0; r < 8; ++r) s_[r] = fadd_s(s_[r], s_[r + 8]); \
              _Pragma("unroll") for (int r = 0; r < 4; ++r) s_[r] = fadd_s(s_[r], s_[r + 4]); \
              ps_ = fadd_s(fadd_s(s_[0], s_[2]), fadd_s(s_[1], s_[3])); } \
            l += swap_sum(ps_); \
            bx8 pa0_, pa1_, pa2_, pa3_; FA_PK4(PX0, 0, pa0_); FA_PK4(PX0, 8, pa1_); FA_PK4(PX1, 0, pa2_); FA_PK4(PX1, 8, pa3_); \
            pvT(o, lds, buf_, I, pa0_, pa1_, pa2_, pa3_); } \
        __syncthreads(); } while (0)
    int it = 0;
    for (; it + 1 < NT; it += 2) { FA_TRIP(pA0, pA1, actA, pB0, pB1, actB, it); FA_TRIP(pB0, pB1, actB, pA0, pA1, actA, it + 1); }
    if (it < NT) FA_TRIP(pA0, pA1, actA, pB0, pB1, actB, it);
#undef FA_TRIP
#undef FA_KT
#undef FA_VT
#undef FA_ACT
}
__device__ __forceinline__ void dil_unit(const bf16* PROJ, bf16* OCAT, float* LSE, int b, int head, int dd, int res, int m0, LAS unsigned char* lds, const Ids& I) {
    const int mq = m0 + I.wid * 32 + I.r32; const size_t row = (size_t)b * SEQ + (size_t)mq * dd + res;
    bx8 qr[8]; load_q(qr, PROJ + row * NP + C_DQ + head * 128, I.hi);
    const bf16* Kh = PROJ + ((size_t)b * SEQ + res) * NP + C_DK + head * 128; const bf16* Vh = PROJ + ((size_t)b * SEQ + res) * NP + C_DV + head * 128;
    f32x16 o[4] = {f32x16{}, f32x16{}, f32x16{}, f32x16{}}; float m = -1e30f, l = 0.f;
    const int j_lo = m0 >= 128 ? (m0 - 128) >> 6 : 0, j_hi = (m0 + 255) >> 6;
    sm_tiles<false>(o, m, l, qr, Kh, Vh, (long)dd * NP, j_lo, j_hi, mq, m0 + I.wid * 32, 129u, 0ull, lds, I);
    store_oT(o, 1.0f / l, OCAT + row * DM + 1536 + head * 128, I.hi);
    if (I.hi == 0) *FA_GW(float, LSE + row * 12 + head) = m + lg2(l);
}
__device__ __forceinline__ void dil_fixup(bf16* OCAT, const float* LSE, int it, int lane) {
    const int i = it & 3; const size_t row = (size_t)(it >> 2);
    const float l0 = LSE[row * 12 + i], l1 = LSE[row * 12 + 4 + i], l2 = LSE[row * 12 + 8 + i], mx = fmaxf(l0, fmaxf(l1, l2));
    const float w0 = ex2(l0 - mx), w1 = ex2(l1 - mx), w2 = ex2(l2 - mx), rden = 1.0f / (w0 + w1 + w2);
#pragma unroll
    for (int gi = 0; gi < 3; ++gi) { unsigned* p = (unsigned*)(OCAT + row * DM + 1536 + (gi * 4 + i) * 128 + 2 * lane); const unsigned w = *p; const float al = (gi == 0 ? w0 : gi == 1 ? w1 : w2) * rden;
        *p = pk2(blo(w) * al, bhi(w) * al); }
}
constexpr int IMP_STRIDE = 68;
template <int MODE  >
__device__ __forceinline__ void acc_oT(const f32x16 (&o)[4], float scale, float* arow, bf16* orow, int hi) {
#pragma unroll
    for (int d0 = 0; d0 < 4; ++d0)
#pragma unroll
        for (int g4 = 0; g4 < 4; ++g4) { f32x4 v = {o[d0][4 * g4] * scale, o[d0][4 * g4 + 1] * scale, o[d0][4 * g4 + 2] * scale, o[d0][4 * g4 + 3] * scale};
            GAS f32x4* p = FA_GW(f32x4, arow + 32 * d0 + 8 * g4 + 4 * hi);
            if (MODE >= 1) v = v + *p;
            if (MODE <= 1) *p = v;
            else { u32x2 w; w.x = cvtpk(v[0], v[1]); w.y = cvtpk(v[2], v[3]); *FA_GW(u32x2, orow + 32 * d0 + 8 * g4 + 4 * hi) = w; } }
}
__device__ __forceinline__ void stage_kc(const float* KC, int b, int g, LAS unsigned char* lds, const Ids& I);
__device__ __forceinline__ void cmp_unit(const bf16* PROJ, const float* KC, float* ACC, unsigned long long* SEL, int b, int g, int t0, LAS unsigned char* lds, const Ids& I) {
    const int tq = t0 + I.wid * 32 + I.r32, wfirst = t0 + I.wid * 32; const size_t row = (size_t)b * SEQ + tq;
    const bf16* prow = PROJ + row * NP;
    stage_kc(KC, b, g, lds, I);
    __syncthreads();
    const int nvalid = (tq + 1) >> 6;
    f32x16 i0 = f32x16{}, i1 = f32x16{};
#pragma unroll 1
    for (int r6 = 0; r6 < 6; ++r6) { const int hh = g * 6 + r6;
        bx8 qr[8]; load_q(qr, prow + C_NQ + hh * 128, I.hi);
        f32x16 p0, p1; qkt(p0, p1, lds, 0, I, qr);
        const float NEG = -__builtin_inff(); float mx = NEG;
#pragma unroll
        for (int r = 0; r < 16; ++r) { if (crow(r, I.hi) >= nvalid) p0[r] = NEG; if (32 + crow(r, I.hi) >= nvalid) p1[r] = NEG; mx = fmaxf(mx, fmaxf(p0[r], p1[r])); }
        mx = swap_max(mx); const float mref = nvalid > 0 ? mx : 0.f; float ps = 0.f;
#pragma unroll
        for (int r = 0; r < 16; ++r) { p0[r] = ex2(p0[r] - mref); p1[r] = ex2(p1[r] - mref); ps += p0[r] + p1[r]; }
        ps = swap_sum(ps); const float rl = nvalid > 0 ? 1.0f / ps : 0.f;
#pragma unroll
        for (int r = 0; r < 16; ++r) { p0[r] *= rl; p1[r] *= rl; i0[r] += p0[r]; i1[r] += p1[r]; }
        bx8 ca0, ca1, ca2, ca3; FA_PK4(p0, 0, ca0); FA_PK4(p0, 8, ca1); FA_PK4(p1, 0, ca2); FA_PK4(p1, 8, ca3);
        f32x16 o[4] = {f32x16{}, f32x16{}, f32x16{}, f32x16{}};
        pvT(o, lds, 0, I, ca0, ca1, ca2, ca3);
        acc_oT<0>(o, PBR(1) * 1.0f / (1.0f + __expf(-bf2f(*FA_G(bf16, prow + C_GT + hh * 3 + 0)))), ACC + row * 1536 + hh * 128, nullptr, I.hi); }
    LAS float* imp = (LAS float*)(lds + L_WS) + (size_t)I.wid * 32 * IMP_STRIDE;
#pragma unroll
    for (int g4 = 0; g4 < 4; ++g4) { *(LAS f32x4*)(imp + I.r32 * IMP_STRIDE + 8 * g4 + 4 * I.hi) = (f32x4){i0[4 * g4], i0[4 * g4 + 1], i0[4 * g4 + 2], i0[4 * g4 + 3]};
        *(LAS f32x4*)(imp + I.r32 * IMP_STRIDE + 32 + 8 * g4 + 4 * I.hi) = (f32x4){i1[4 * g4], i1[4 * g4 + 1], i1[4 * g4 + 2], i1[4 * g4 + 3]}; }
    LDS_WAIT(); asm volatile("" ::: "memory");
#pragma unroll 1
    for (int tk = 0; tk < 32; ++tk) { const int t = wfirst + tk, cur = t >> 6, n = I.lane;
        const float v = imp[tk * IMP_STRIDE + n];
        const bool forced = (n == 0) || (n == cur) || (n == cur - 1), started = n <= cur;
        const float score = forced ? 7.0f : (started ? v : -1.0f);
        const int sb_ = (int)__float_as_uint(score); const unsigned key = sb_ < 0 ? 0u : (unsigned)sb_ + 1u;
        unsigned T = 0u;
#pragma unroll
        for (int bit = 31; bit >= 0; --bit) { const unsigned cand = T | (1u << bit); if (__popcll(__ballot(key >= cand)) >= 16) T = cand; }
        const unsigned long long gt = __ballot(key > T); unsigned long long eq = __ballot(key == T), mk = gt;
        for (int need = 16 - __popcll(gt); need > 0; --need) { const unsigned long long lowest = eq & (0ull - eq); mk |= lowest; eq ^= lowest; }
        if (n == 0) *FA_GW(unsigned long long, SEL + (size_t)(b * 2 + g) * SEQ + t) = mk; }
    __syncthreads();
}
__device__ __forceinline__ void nsa_unit(const bf16* PROJ, const bf16* KVC, const unsigned long long* SEL, float* ACC, bf16* OCAT, int b, int h, int t0, LAS unsigned char* lds, const Ids& I, volatile LAS unsigned* misc = nullptr) {
#define NACC(k) do { } while (0)
    const int g = h / 6, tq = t0 + I.wid * 32 + I.r32, wfirst = t0 + I.wid * 32;
    const unsigned long long selmask = *FA_G(unsigned long long, SEL + (size_t)(b * 2 + g) * SEQ + tq);
    NACC(0);
    bx8 qr[8]; { int tq_ = tq; asm volatile("" : "+v"(tq_)); load_q(qr, PROJ + ((size_t)b * SEQ + tq_) * NP + C_NQ + h * 128, I.hi); }
    const int j_hi = (t0 >> 6) + 3;
    for (int repb_ = 0; repb_ < NSA_REP_B; ++repb_)
    {
        float zs_ = (repb_ + 1 == NSA_REP_B) ? 1.0f : 0.0f; asm volatile("" : "+v"(zs_));
        f32x16 o[4] = {f32x16{}, f32x16{}, f32x16{}, f32x16{}}; float m = -1e30f, l = 0.f;
        sm_tiles<true>(o, m, l, qr, KVC + ((size_t)(0 + g) * MTOK + (size_t)b * SEQ) * 128, KVC + ((size_t)(4 + g) * MTOK + (size_t)b * SEQ) * 128, 128L, 0, j_hi, tq, wfirst, 0x7fffffffu, selmask, lds, I);
        int tq_ = tq; asm volatile("" : "+v"(tq_)); const size_t row_ = (size_t)b * SEQ + tq_;
        acc_oT<1>(o, zs_ * PBR(2) * (1.0f / (1.0f + __expf(-bf2f(*FA_G(bf16, PROJ + row_ * NP + C_GT + h * 3 + 1))))) / l, ACC + row_ * 1536 + h * 128, nullptr, I.hi);
    }
    NACC(1);
    for (int repc_ = 0; repc_ < NSA_REP_C; ++repc_)
    {
        float zs_ = (repc_ + 1 == NSA_REP_C) ? 1.0f : 0.0f; asm volatile("" : "+v"(zs_));
        f32x16 o[4] = {f32x16{}, f32x16{}, f32x16{}, f32x16{}}; float m = -1e30f, l = 0.f;
        const int j_lo = t0 >= 512 ? (t0 - 511) >> 6 : 0;
        sm_tiles<false>(o, m, l, qr, KVC + ((size_t)(2 + g) * MTOK + (size_t)b * SEQ) * 128, KVC + ((size_t)(6 + g) * MTOK + (size_t)b * SEQ) * 128, 128L, j_lo, j_hi, tq, wfirst, 512u, 0ull, lds, I);
        int tq_ = tq; asm volatile("" : "+v"(tq_)); const size_t row_ = (size_t)b * SEQ + tq_;
        if (repc_ + 1 < NSA_REP_C) acc_oT<1>(o, zs_ / l, ACC + row_ * 1536 + h * 128, nullptr, I.hi); else
        acc_oT<2>(o, PBR(3) * (1.0f / (1.0f + __expf(-bf2f(*FA_G(bf16, PROJ + row_ * NP + C_GT + h * 3 + 2))))) / l, ACC + row_ * 1536 + h * 128, OCAT + row_ * DM + h * 128, I.hi);
    }
    NACC(2);
#undef NACC
}

__device__ __forceinline__ void compress_unit(const bf16* PROJ, const bf16* W1t, const float* PEP, const float* w2, float* KC, int cu, LAS unsigned char* lds, const Ids& I, unsigned* done) {
    const int ten = cu >> 6, rt = (cu >> 3) & 7, ct = cu & 7, ccol = ten ? C_VC : C_KC;
    const int rowi = rt * 32 + I.r32, g = rowi & 1, n = (rowi >> 1) & 63, b = rowi >> 7;
    const bf16* arow = PROJ + ((size_t)b * SEQ + n * 64 + I.wid * 8) * NP + ccol + g * 128 + 8 * I.hi;
    const bf16* brow = W1t + ((size_t)ten * 256 + ct * 32 + I.r32) * 8192 + I.wid * 1024 + 8 * I.hi;
    f32x16 acc = f32x16{};
#pragma unroll 1
    for (int s8 = 0; s8 < 64; s8 += 8) {
        bx8 a[8], w[8];
#pragma unroll
        for (int s = 0; s < 8; ++s) { a[s] = *FA_G(bx8, arow + (size_t)(s8 >> 3) * NP + 16 * s); w[s] = *FA_G(bx8, brow + (s8 + s) * 16); }
#pragma unroll
        for (int s = 0; s < 8; ++s) acc = __builtin_amdgcn_mfma_f32_32x32x16_bf16(a[s], w[s], acc, 0, 0, 0);
    }
    LAS float* red = (LAS float*)lds;
#pragma unroll
    for (int r = 0; r < 16; ++r) red[(I.wid * 32 + crow(r, I.hi)) * 32 + I.r32] = acc[r];
    __syncthreads();
    LAS float* hid = red + 8 * 1024;
    LAS float* pew = hid + 32 * 33;
    const int tid = I.wid * 64 + I.lane;
    if (tid < 32) pew[tid] = fx_get(PEP + 2 * ((size_t)ten * 256 + ct * 32 + tid), FX_KC_INV);
    __syncthreads();
    for (int e = tid; e < 1024; e += 512) { float hsum = pew[e & 31];
#pragma unroll
        for (int w = 0; w < 8; ++w) hsum += red[w * 1024 + e];
        hid[(e >> 5) * 33 + (e & 31)] = hsum / (1.0f + __expf(-hsum)); }
    __syncthreads();
    { const int r = tid >> 4, dg = tid & 15; f32x4 o0 = {0.f, 0.f, 0.f, 0.f}, o1 = {0.f, 0.f, 0.f, 0.f};
#pragma unroll 8
        for (int c = 0; c < 32; ++c) { const float hv = hid[r * 33 + c]; const GAS f32x4* wp = FA_G(f32x4, w2 + (size_t)(ct * 32 + c) * 128 + 8 * dg); o0 += hv * wp[0]; o1 += hv * wp[1]; }
        float* dst = KC + 2 * (((size_t)ten * 256 + rt * 32 + r) * 128 + 8 * dg);
#pragma unroll
        for (int e = 0; e < 4; ++e) { fx_add(dst + 2 * e, o0[e], FX_KC); fx_add(dst + 2 * (4 + e), o1[e], FX_KC); } }
    asm volatile("s_waitcnt vmcnt(0)" ::: "memory");
    __syncthreads();
    if (tid == 0) { __builtin_amdgcn_fence(__ATOMIC_RELEASE, "agent"); asm volatile("s_waitcnt vmcnt(0)" ::: "memory");
        __hip_atomic_fetch_add(done, 1u, __ATOMIC_RELAXED, __HIP_MEMORY_SCOPE_AGENT); }
}
__device__ __forceinline__ void stage_kc(const float* KC, int b, int g, LAS unsigned char* lds, const Ids& I) {
    typedef long long ll2 __attribute__((ext_vector_type(2)));
    const float* kb = KC + 2 * (((size_t)(b * 64) * 2 + g) * 128 + I.sc); const float* vb = kb + 2 * ((size_t)256 * 128);
#define FA_KC4(name, p) f32x4 name; { const ll2 a_ = *FA_G(ll2, p), b_ = *FA_G(ll2, (p) + 4); name = (f32x4){(float)a_.x * FX_KC_INV, (float)a_.y * FX_KC_INV, (float)b_.x * FX_KC_INV, (float)b_.y * FX_KC_INV}; }
    FA_KC4(k00, kb + 2 * ((size_t)I.sr * 256)); FA_KC4(k01, kb + 2 * ((size_t)I.sr * 256 + 4)); FA_KC4(k10, kb + 2 * ((size_t)(32 + I.sr) * 256)); FA_KC4(k11, kb + 2 * ((size_t)(32 + I.sr) * 256 + 4));
    FA_KC4(v00, vb + 2 * ((size_t)I.sr * 256)); FA_KC4(v01, vb + 2 * ((size_t)I.sr * 256 + 4)); FA_KC4(v10, vb + 2 * ((size_t)(32 + I.sr) * 256)); FA_KC4(v11, vb + 2 * ((size_t)(32 + I.sr) * 256 + 4));
#undef FA_KC4
    Stage st;
    { u32x4 w = {cvtpk(k00[0], k00[1]), cvtpk(k00[2], k00[3]), cvtpk(k01[0], k01[1]), cvtpk(k01[2], k01[3])}; st.k0 = __builtin_bit_cast(bx8, w); }
    { u32x4 w = {cvtpk(k10[0], k10[1]), cvtpk(k10[2], k10[3]), cvtpk(k11[0], k11[1]), cvtpk(k11[2], k11[3])}; st.k1 = __builtin_bit_cast(bx8, w); }
    { u32x4 w = {cvtpk(v00[0], v00[1]), cvtpk(v00[2], v00[3]), cvtpk(v01[0], v01[1]), cvtpk(v01[2], v01[3])}; st.v0 = __builtin_bit_cast(bx8, w); }
    { u32x4 w = {cvtpk(v10[0], v10[1]), cvtpk(v10[2], v10[3]), cvtpk(v11[0], v11[1]), cvtpk(v11[2], v11[3])}; st.v1 = __builtin_bit_cast(bx8, w); }
    stage_write(st, lds, 0, I);
}
}
constexpr int CV_NB_IN = (NSRC + 63) / 64, CV_IN = 64 * CV_NB_IN, CV_OUT = 64 * 64, CV_UP = 64 * 256, CV_DN = 256 * 64, CV_L = CV_IN + CV_OUT + CV_UP + CV_DN;
#ifndef CVQ_A
#define CVQ_A 5500
#endif
#ifndef CVQ_P0
#define CVQ_P0 2
#endif
#ifndef CVQ_P1
#define CVQ_P1 3
#endif
#ifndef CVQ_A0
#define CVQ_A0 9000
#endif
constexpr int CVQ_LO[4] = {CV_IN, CV_IN + CV_OUT + CVQ_A0, CV_L + CV_IN, CV_L + CV_IN + CV_OUT + CVQ_A};
constexpr int CVQ_HI[4] = {CV_IN + CV_OUT + CVQ_A0, CV_L + CV_IN, CV_L + CV_IN + CV_OUT + CVQ_A, 2 * CV_L};
__device__ __forceinline__ bool cv_deferred(int it) { return DEFER_CONV && ((it >= CVQ_LO[0] && it < CVQ_HI[1]) || (it >= CVQ_LO[2] && it < CVQ_HI[3])); }
__device__ __forceinline__ void conv_item(const Frame& F, int it, int lane) {
    const int L = it / CV_L; int r = it - L * CV_L;
    if (r < CV_IN) { transpose_item<true>(PIN(1) + (size_t)L * DM * NSRC, DM, NSRC, PWS(bf16, WS_WIN) + (size_t)L * NP * DM, r / CV_NB_IN, r % CV_NB_IN, lane, nullptr, nullptr, PIN(3) + (size_t)L * DM); return; } r -= CV_IN;
    if (r < CV_OUT) { transpose_item<false>(PIN(2) + (size_t)L * DM * DM, DM, DM, PWS(bf16, WS_WOUT) + (size_t)L * DM * DM, r / 64, r % 64, lane); return; } r -= CV_OUT;
    if (r < CV_UP) { transpose_item<false>(PIN(5) + (size_t)L * DM * DFF, DM, DFF, PWS(bf16, WS_WUP) + (size_t)L * DFF * DM, r / 256, r % 256, lane, nullptr, nullptr, PIN(4) + (size_t)L * DM); return; } r -= CV_UP;
    transpose_item<false>(PIN(6) + (size_t)L * DFF * DM, DFF, DM, PWS(bf16, WS_WDN) + (size_t)L * DM * DFF, r / 64, r % 64, lane);
}
__device__ __forceinline__ TrItem conv_make(const Frame& F, int it, int lane) {
    const int L = it / CV_L; int r = it - L * CV_L;
    if (r < CV_IN) return tr_make(PIN(1) + (size_t)L * DM * NSRC, DM, NSRC, PWS(bf16, WS_WIN) + (size_t)L * NP * DM, r / CV_NB_IN, r % CV_NB_IN, lane, PIN(3) + (size_t)L * DM, true); r -= CV_IN;
    if (r < CV_OUT) return tr_make(PIN(2) + (size_t)L * DM * DM, DM, DM, PWS(bf16, WS_WOUT) + (size_t)L * DM * DM, r / 64, r % 64, lane, nullptr, false); r -= CV_OUT;
    if (r < CV_UP) return tr_make(PIN(5) + (size_t)L * DM * DFF, DM, DFF, PWS(bf16, WS_WUP) + (size_t)L * DFF * DM, r / 256, r % 256, lane, PIN(4) + (size_t)L * DM, false); r -= CV_UP;
    return tr_make(PIN(6) + (size_t)L * DFF * DM, DFF, DM, PWS(bf16, WS_WDN) + (size_t)L * DM * DFF, r / 64, r % 64, lane, nullptr, false);
}
template <int CH> __device__ __forceinline__ bool conv_chunk(const Frame& F, const Ctx& C, int q) {
    const int lo_ = q == 0 ? CVQ_LO[0] : q == 1 ? CVQ_LO[1] : q == 2 ? CVQ_LO[2] : CVQ_LO[3], hi_ = q == 0 ? CVQ_HI[0] : q == 1 ? CVQ_HI[1] : q == 2 ? CVQ_HI[2] : CVQ_HI[3];
    if (C.wave == 0 && fresh_lane() == 0) F.MISC[52] = __hip_atomic_fetch_add(PWS(unsigned, WS_CTL) + 251000 + 64 * q, 1u, __ATOMIC_RELAXED, __HIP_MEMORY_SCOPE_AGENT);
    __syncthreads(); const int c = (int)__builtin_amdgcn_readfirstlane((int)F.MISC[52]); __syncthreads();
    const long base = (long)lo_ + (long)c * (8 * CH); if (base >= hi_) return false;
    const int lane = fresh_lane();
    if constexpr (CH == 4) {
        const long it0 = base + C.wave * CH; const int nit = (hi_ - it0) < CH ? (int)(hi_ - it0) : CH;
        if (nit == CH) { f32x4 va[16], vb[16];
            TrItem ta = conv_make(F, (int)it0, lane); tr_load(va, ta);
            TrItem tb = conv_make(F, (int)it0 + 1, lane); tr_load(vb, tb);
            tr_store(va, ta); ta = conv_make(F, (int)it0 + 2, lane); tr_load(va, ta);
            tr_store(vb, tb); tb = conv_make(F, (int)it0 + 3, lane); tr_load(vb, tb);
            tr_store(va, ta); tr_store(vb, tb);
        } else {
#pragma unroll 1
            for (int j = 0; j < nit; ++j) conv_item(F, (int)(it0 + j), lane); }
    } else {
#pragma unroll 1
    for (int j = 0; j < CH; ++j) { const long it = base + C.wave * CH + j; if (it < hi_) conv_item(F, (int)it, lane); }
    }
    return true;
}
__device__ __forceinline__ void p0_prologue(const Frame& F, const Ctx& C) {
    const int lane = C.lane, tid = C.tid;
    {
        bf16* Win_t = PWS(bf16, WS_WIN);
        for (int rep_ = 0; rep_ < NREP(0); ++rep_)
        for (int it = C.gw; it < DEPTH * CV_L; it += C.ngw) { if (!cv_deferred(it)) conv_item(F, it, lane); }
        for (int it = C.gw; it < DEPTH * (NP - NSRC); it += C.ngw) { const int L = it / (NP - NSRC), r = NSRC + it % (NP - NSRC);
            v4u* p = (v4u*)(Win_t + (size_t)L * NP * DM + (size_t)r * DM); const v4u z = {0u, 0u, 0u, 0u};
#pragma unroll
            for (int j = 0; j < 8; ++j) p[lane + 64 * j] = z; }
    }
    for (int rep9_ = 0; rep9_ < NREP(9); ++rep9_) {
    {
        bf16* W1t = PWS(bf16, WS_W1T); float* PEP = PWS(float, WS_PEP);
        for (int it = C.gw; it < DEPTH * 2 * 512; it += C.ngw) { const int lt = it >> 9, r = it & 511; const float* w1 = PIN((lt & 1) ? 11 : 9) + (size_t)(lt >> 1) * 8192 * 256;
            transpose_item<false, true>(w1, 8192, 256, W1t + (size_t)lt * 256 * 8192, r >> 2, r & 3, lane, PIN((lt & 1) ? 8 : 7) + (size_t)(lt >> 1) * 8192, PEP + (size_t)lt * 2 * 256); }
        float* KC = PWS(float, WS_KC); for (int e = C.gw * 64 + lane; e < 2 * 2 * 256 * 128; e += C.ngw * 64) KC[e] = 0.f;
    }
    {
        float* cosT = PWS(float, WS_COS); float* sinT = PWS(float, WS_SIN);
        for (int e = C.bid * (NWAVES * 64) + tid; e < SEQ * 64; e += C.G * NWAVES * 64) { const int t = e >> 6, i = e & 63;
            double p = 1.0; for (int k = 0; k < i; ++k) p *= 1.1547819846894583;
            const float pf = (float)p, inv = (float)(1.0 / (double)pf), ang = __fmul_rn((float)t, inv);
            double s, c; sincos_red((double)ang, s, c); cosT[e] = (float)c; sinT[e] = (float)s; }
    }
    raw_phase(C, PIN(0), PWS(bf16, WS_H), PWS(float, WS_SS));
    }
}

__device__ __forceinline__ float dot128_bf(const LAS float* q, const bf16* krow) {
    float s0 = 0.f, s1 = 0.f;
#pragma unroll 1
    for (int c4 = 0; c4 < 16; c4 += 4) {
#pragma unroll
        for (int cc = 0; cc < 4; ++cc) { const int c = c4 + cc; const v4u kk = *(const v4u*)(krow + 8 * c); const f32x4 qa = *(const LAS f32x4*)(q + 8 * c), qb = *(const LAS f32x4*)(q + 8 * c + 4);
            s0 = fmaf(qa.x, blo(kk.x), s0); s1 = fmaf(qa.y, bhi(kk.x), s1); s0 = fmaf(qa.z, blo(kk.y), s0); s1 = fmaf(qa.w, bhi(kk.y), s1);
            s0 = fmaf(qb.x, blo(kk.z), s0); s1 = fmaf(qb.y, bhi(kk.z), s1); s0 = fmaf(qb.z, blo(kk.w), s0); s1 = fmaf(qb.w, bhi(kk.w), s1); } }
    return s0 + s1;
}
__device__ __forceinline__ float dot128_f(const LAS float* q, const float* krow) {
    float s0 = 0.f, s1 = 0.f;
#pragma unroll 1
    for (int c8 = 0; c8 < 32; c8 += 8) {
#pragma unroll
        for (int cc = 0; cc < 8; ++cc) { const int c = c8 + cc; const f32x4 kk = *(const f32x4*)(krow + 4 * c), qa = *(const LAS f32x4*)(q + 4 * c);
            s0 = fmaf(qa.x, kk.x, s0); s1 = fmaf(qa.y, kk.y, s1); s0 = fmaf(qa.z, kk.z, s0); s1 = fmaf(qa.w, kk.w, s1); } }
    return s0 + s1;
}
__device__ __forceinline__ void load_q(LAS float* qs, const bf16* qrow, int lane) {
    const unsigned w = *(const unsigned*)(qrow + 2 * lane); qs[2 * lane] = blo(w); qs[2 * lane + 1] = bhi(w); LDS_WAIT(); asm volatile("" ::: "memory");
}
struct SmState { float m, l, o0, o1; };
__device__ __forceinline__ void sm_chunk(SmState& S, float s, const bf16* vrow0, long vstep, int nk, LAS float* ps, int lane) {
    const float mx = wave_max(s), mn = fmaxf(S.m, mx), alpha = ex2(S.m - mn), p = ex2(s - mn);
    S.l = S.l * alpha + wave_sum(p); S.o0 *= alpha; S.o1 *= alpha; S.m = mn;
    asm volatile("" ::: "memory"); ps[lane] = p; LDS_WAIT(); asm volatile("" ::: "memory");
#pragma unroll 4
    for (int k = 0; k < nk; ++k) { const float pk = ps[k]; const unsigned w = *(const unsigned*)(vrow0 + (long)k * vstep + 2 * lane); S.o0 = fmaf(pk, blo(w), S.o0); S.o1 = fmaf(pk, bhi(w), S.o1); }
    LDS_WAIT(); asm volatile("" ::: "memory");
}
__device__ __forceinline__ void compress_item(const Frame& F, const Ctx& C, int L, int item) {
    const int lane = C.lane, tid = C.tid;
    const int ten = item >> 5, rg = item & 31;
    const float* w1 = PIN(ten ? 11 : 9) + (size_t)L * 8192 * 256; const float* w2 = PIN(ten ? 12 : 10) + (size_t)L * 256 * 128;
    const float* pe = PIN(ten ? 8 : 7) + (size_t)L * 8192; const int ccol = ten ? C_VC : C_KC;
    const bf16* PROJ = PWS(bf16, WS_PROJ); float* KC = PWS(float, WS_KC) + (PROBE_SEC == 4 ? 65536 : 0);
    float acc[8][4];
#pragma unroll
    for (int i = 0; i < 8; ++i)
#pragma unroll
        for (int jb = 0; jb < 4; ++jb) acc[i][jb] = 0.f;
    for (int k0 = C.wave * 1024; k0 < C.wave * 1024 + 1024; k0 += 64) {
        const int tok = k0 >> 7, d = (k0 & 127) + lane; float a[8];
#pragma unroll
        for (int i = 0; i < 8; ++i) { const int r = rg * 8 + i, g = r & 1, n = (r >> 1) & 63, b = r >> 7;
            a[i] = bf2f(PROJ[(size_t)(b * SEQ + n * 64 + tok) * NP + ccol + g * 128 + d]) + pe[k0 + lane]; }
#pragma unroll 4
        for (int kk = 0; kk < 64; ++kk) { const float* wr = w1 + (size_t)(k0 + kk) * 256 + lane; float wv[4];
#pragma unroll
            for (int jb = 0; jb < 4; ++jb) wv[jb] = wr[64 * jb];
#pragma unroll
            for (int i = 0; i < 8; ++i) { const float ai = __shfl(a[i], kk);
#pragma unroll
                for (int jb = 0; jb < 4; ++jb) acc[i][jb] = fmaf(ai, wv[jb], acc[i][jb]); } }
    }
    LAS float* red = (LAS float*)(C.lds + RING_OFF);
#pragma unroll
    for (int i = 0; i < 8; ++i)
#pragma unroll
        for (int jb = 0; jb < 4; ++jb) red[(C.wave * 8 + i) * 256 + jb * 64 + lane] = acc[i][jb];
    __syncthreads();
    LAS float* hid = red + 8 * 8 * 256;
    for (int e = tid; e < 8 * 256; e += NWAVES * 64) { float h = 0.f;
#pragma unroll
        for (int w = 0; w < 8; ++w) h += red[w * 2048 + e];
        hid[e] = h / (1.0f + __expf(-h)); }
    __syncthreads();
    { const int i = C.wave; float o0 = 0.f, o1 = 0.f;
        for (int j = 0; j < 256; ++j) { const float hv = hid[i * 256 + j]; o0 = fmaf(hv, w2[j * 128 + lane], o0); o1 = fmaf(hv, w2[j * 128 + 64 + lane], o1); }
#if PROBE_SEC >= 1 && PROBE_SEC <= 3
        o0 = __uint_as_float(f2bf(o0) << 16); o1 = __uint_as_float(f2bf(o1) << 16);
#endif
        float* dst = KC + ((size_t)ten * 256 + rg * 8 + i) * 128; dst[lane] = o0; dst[64 + lane] = o1;
        bf16* dsb = PWS(bf16, WS_KCB) + ((size_t)ten * 256 + rg * 8 + i) * 128; dsb[lane] = (bf16)f2bf(o0); dsb[64 + lane] = (bf16)f2bf(o1); }
    __syncthreads();
}
__device__ __forceinline__ void dil_item(const bf16* PROJ, bf16* OCAT, int it, LAS float* qs, LAS float* ps, int lane) {
    const int i = it & 3, t = (it >> 2) & (SEQ - 1), b = it >> 14; const size_t row = (size_t)b * SEQ + t;
    LAS float* og = qs + 256;
#pragma unroll 1
    for (int gi = 0; gi < 3; ++gi) { const int head = gi * 4 + i, dd = 1 << (2 * gi);
        load_q(qs, PROJ + row * NP + C_DQ + head * 128, lane);
        SmState S; S.m = -1e30f; S.l = 0.f; S.o0 = 0.f; S.o1 = 0.f;
#pragma unroll 1
        for (int c = 0; c < 3; ++c) { const int k = c * 64 + lane, key = t - k * dd; const bool valid = (k <= 128) && (key >= 0);
            float s = dot128_bf(qs, PROJ + ((size_t)b * SEQ + (valid ? key : t)) * NP + C_DK + head * 128); if (!valid) s = -__builtin_inff();
            int nk = 129 - c * 64; if (nk > 64) nk = 64; const int kmax = t / dd - c * 64 + 1; if (nk > kmax) nk = kmax;
            if (nk > 0) sm_chunk(S, s, PROJ + ((size_t)b * SEQ + (t - c * 64 * dd)) * NP + C_DV + head * 128, -(long)dd * NP, nk, ps, lane); }
        const float rl = 1.0f / S.l; og[gi * 128 + 2 * lane] = S.o0 * rl; og[gi * 128 + 2 * lane + 1] = S.o1 * rl; if (lane == 0) og[384 + gi] = S.m + lg2(S.l); }
    LDS_WAIT(); asm volatile("" ::: "memory");
    const float l0 = og[384], l1 = og[385], l2 = og[386], mx = fmaxf(l0, fmaxf(l1, l2));
    const float w0 = ex2(l0 - mx), w1 = ex2(l1 - mx), w2 = ex2(l2 - mx), rden = 1.0f / (w0 + w1 + w2);
#pragma unroll 1
    for (int gi = 0; gi < 3; ++gi) { const float al = (gi == 0 ? w0 : gi == 1 ? w1 : w2) * rden;
        *(unsigned*)(OCAT + row * DM + 1536 + (gi * 4 + i) * 128 + 2 * lane) = pk2(og[gi * 128 + 2 * lane] * al, og[gi * 128 + 2 * lane + 1] * al); }
    LDS_WAIT(); asm volatile("" ::: "memory");
}
__device__ __forceinline__ void sb_item(const bf16* PROJ, bf16* OCAT, int it, LAS float* qs, LAS float* ps, int lane) {
    const int h = it & 7, t = (it >> 3) & (SEQ - 1), b = it >> 15; const size_t row = (size_t)b * SEQ + t;
    load_q(qs, PROJ + row * NP + C_SQ + h * 128, lane);
    float R = 0.f, o0 = 0.f, o1 = 0.f;
#pragma unroll 1
    for (int c = 0; c * 64 < t; ++c) { const int key = t - 1 - (c * 64 + lane); const bool valid = key >= 0;
        const float z = dot128_bf(qs, PROJ + ((size_t)b * SEQ + (valid ? key : 0)) * NP + C_SK + h * 128);
        const float e = ex2(-fabsf(z)), lg = lg2(1.0f + e), lb = fminf(z, 0.f) - lg, l1m = valid ? (lb - z) : 0.f;
        float incl = l1m;
#pragma unroll
        for (int o = 1; o < 64; o <<= 1) { const float u = __shfl_up(incl, o); if (lane >= o) incl += u; }
        const float a = valid ? ex2(lb + R + (incl - l1m)) : 0.f;
        R += __shfl(incl, 63);
        asm volatile("" ::: "memory"); ps[lane] = a; LDS_WAIT(); asm volatile("" ::: "memory");
        int nk = t - c * 64; if (nk > 64) nk = 64;
        const bf16* v0 = PROJ + ((size_t)b * SEQ + (t - 1 - c * 64)) * NP + C_SV + h * 128 + 2 * lane;
#pragma unroll 4
        for (int k = 0; k < nk; ++k) { const float pk = ps[k]; const unsigned w = *(const unsigned*)(v0 - (long)k * NP); o0 = fmaf(pk, blo(w), o0); o1 = fmaf(pk, bhi(w), o1); }
        LDS_WAIT(); asm volatile("" ::: "memory"); }
    *(unsigned*)(OCAT + row * DM + 3072 + h * 128 + 2 * lane) = pk2(o0, o1);
}
__device__ __forceinline__ void cmp_item(const bf16* PROJ, const float* KC, float* OCMP, unsigned long long* SEL, int it, LAS float* qs, LAS float* ps, int lane) {
    const int t = it & (SEQ - 1), g = (it >> 12) & 1, b = it >> 13; const size_t row = (size_t)b * SEQ + t;
    const int nvalid = (t + 1) >> 6, cur = t >> 6; const bool valid = lane < nvalid; float imp = 0.f;
#pragma unroll 1
    for (int r = 0; r < 6; ++r) { const int h = g * 6 + r;
        load_q(qs, PROJ + row * NP + C_NQ + h * 128, lane);
        const float s = dot128_f(qs, KC + ((size_t)(b * 64 + lane) * 2 + g) * 128);
        float p = 0.f;
        if (nvalid > 0) { const float m = wave_max(valid ? s : -__builtin_inff()), e = valid ? ex2(s - m) : 0.f, l = wave_sum(e); p = e / l; }
        imp += p;
        asm volatile("" ::: "memory"); ps[lane] = p; LDS_WAIT(); asm volatile("" ::: "memory");
        float o0 = 0.f, o1 = 0.f;
#pragma unroll 4
        for (int n = 0; n < nvalid; ++n) { const float pn = ps[n]; const float2 v = *(const float2*)(KC + ((size_t)256 + (b * 64 + n) * 2 + g) * 128 + 2 * lane); o0 = fmaf(pn, v.x, o0); o1 = fmaf(pn, v.y, o1); }
        LDS_WAIT(); asm volatile("" ::: "memory");
        *(float2*)(OCMP + row * 1536 + h * 128 + 2 * lane) = make_float2(o0, o1); }
    const bool forced = (lane == 0) || (lane == cur) || (lane == cur - 1), started = lane <= cur;
    const float score = forced ? 7.0f : (started ? imp : -1.0f);
    int rank = 0;
#pragma unroll 8
    for (int i = 0; i < 64; ++i) { const float vi = __shfl(score, i); rank += ((vi > score) || (vi == score && i < lane)) ? 1 : 0; }
    const unsigned long long mask = __ballot(rank < 16);
    if (lane == 0) SEL[(size_t)(b * 2 + g) * SEQ + t] = mask;
}
__device__ __forceinline__ void nsa_item(const bf16* PROJ, const bf16* KVC, const float* OCMP, const unsigned long long* SEL, bf16* OCAT, int it, LAS float* qs, LAS float* ps, int lane) {
    const int h = it % 12, bt = it / 12, t = bt & (SEQ - 1), b = bt >> 12, g = h / 6; const size_t row = (size_t)b * SEQ + t;
    const bf16* prow = PROJ + row * NP;
    load_q(qs, prow + C_NQ + h * 128, lane);
    const unsigned long long mask = SEL[(size_t)(b * 2 + g) * SEQ + t]; const int cur = t >> 6;
    SmState S; S.m = -1e30f; S.l = 0.f; S.o0 = 0.f; S.o1 = 0.f;
#pragma unroll 1
    for (int j = 0; j <= cur; ++j) { if (!((mask >> j) & 1ull)) continue;
        const int key = j * 64 + lane; float s = dot128_bf(qs, KVC + ((size_t)(0 + g) * MTOK + (size_t)b * SEQ + key) * 128); if (key > t) s = -__builtin_inff();
        int nk = t - j * 64 + 1; if (nk > 64) nk = 64;
        sm_chunk(S, s, KVC + ((size_t)(4 + g) * MTOK + (size_t)b * SEQ + j * 64) * 128, 128L, nk, ps, lane); }
    const float rs = 1.0f / S.l, os0 = S.o0 * rs, os1 = S.o1 * rs;
    S.m = -1e30f; S.l = 0.f; S.o0 = 0.f; S.o1 = 0.f;
    const int lowk = t - 511 > 0 ? t - 511 : 0;
#pragma unroll 1
    for (int kb = lowk & ~63; kb <= t; kb += 64) { const int key = kb + lane; const bool valid = key >= lowk && key <= t;
        float s = dot128_bf(qs, KVC + ((size_t)(2 + g) * MTOK + (size_t)b * SEQ + key) * 128); if (!valid) s = -__builtin_inff();
        int nk = t - kb + 1; if (nk > 64) nk = 64;
        sm_chunk(S, s, KVC + ((size_t)(6 + g) * MTOK + (size_t)b * SEQ + kb) * 128, 128L, nk, ps, lane); }
    const float rw = 1.0f / S.l, ow0 = S.o0 * rw, ow1 = S.o1 * rw;
    const float g0 = 1.0f / (1.0f + __expf(-bf2f(prow[C_GT + h * 3 + 0]))), g1 = 1.0f / (1.0f + __expf(-bf2f(prow[C_GT + h * 3 + 1]))), g2 = 1.0f / (1.0f + __expf(-bf2f(prow[C_GT + h * 3 + 2])));
    const float2 oc = *(const float2*)(OCMP + row * 1536 + h * 128 + 2 * lane);
    *(unsigned*)(OCAT + row * DM + h * 128 + 2 * lane) = pk2(PBR(1) * g0 * oc.x + PBR(2) * g1 * os0 + PBR(3) * g2 * ow0, PBR(1) * g0 * oc.y + PBR(2) * g1 * os1 + PBR(3) * g2 * ow1);
}

#define PH_LO() (__builtin_amdgcn_readfirstlane((int)F.MISC[53]))
#define PH_HI() (__builtin_amdgcn_readfirstlane((int)F.MISC[54]))
#define IN(k) (PH_LO() <= (k) && (k) < PH_HI())
#define SEAM(k) do { if (IN(k) && IN((k) + 1)) { TSTAMP(); for (int rs_ = 0; rs_ < NREP(12); ++rs_) { XcdBarrier b_; b_.bar = PWS(unsigned, WS_CTL) + CW_BAR + PH_LO() * XCD_BAR_WORDS; b_.x = xb_xcc_id(); b_.st = F.MISC + 8; xcd_barrier(b_); } TSTAMP(); } } while (0)
#define QS ((LAS float*)(C.lds + RING_OFF + C.wave * 4096))
#define PS (QS + 128)
#if PROBE_SEC
__device__ __forceinline__ void probe_phases(const Frame& F) {

    SEAM(1);
#if PROBE_SEC == 5
    if (IN(2)) { CTX();
        const bf16* PROJ = PWS(bf16, WS_PROJ); const bf16* KVC = PWS(bf16, WS_KVC); float* out = (float*)rd_ptr(F, PT_OUT);
        for (size_t e = (size_t)C.gw * 64 + C.lane; e < (size_t)MTOK * DM; e += (size_t)C.ngw * 64) { const int col = (int)(e & (DM - 1)); const size_t row = e >> 12; float v = 0.f;
            if (col < 1024) { const int hd = col >> 7, d = col & 127, kind = hd >> 1, g = hd & 1; const int cb = kind == 0 ? C_KS : kind == 1 ? C_KW : kind == 2 ? C_VS : C_VW;
                v = (float)PROBE_C * (bf2f(KVC[((size_t)hd * MTOK + row) * 128 + d]) - bf2f(PROJ[row * NP + cb + g * 128 + d])); }
            out[e] = v; } }
    return;
#endif
#if PROBE_SEC == 4
    if (IN(2)) { CTX();
        const bf16* PROJ = PWS(bf16, WS_PROJ); const fa::Ids I = fa::make_ids(C.wave, C.lane);
        const bf16* W1t = PWS(bf16, WS_W1T); const float* PEP = PWS(float, WS_PEP); float* KC = PWS(float, WS_KC);
        for (int u = C.bid; u < 128; u += C.G) fa::compress_unit(PROJ, W1t, PEP, PIN((u >> 6) ? 12 : 10), KC, u, C.lds + RING_OFF, I);
        __syncthreads();
        for (int it = C.bid; it < 64; it += C.G) compress_item(F, C, 0, it);
        SEAM(2); }
    if (IN(3)) { CTX();
        const float* KC = PWS(float, WS_KC); float* out = (float*)rd_ptr(F, PT_OUT);
        for (size_t e = (size_t)C.gw * 64 + C.lane; e < (size_t)MTOK * DM; e += (size_t)C.ngw * 64) out[e] = e < 65536 ? (float)PROBE_C * (KC[e] - KC[e + 65536]) : 0.f; }
    return;
#endif
    if (IN(2)) { CTX();
        for (int it = C.bid; it < 64; it += C.G) compress_item(F, C, 0, it);
        const int lane = C.lane; const bf16* PROJ = PWS(bf16, WS_PROJ); bf16* OCAT = PWS(bf16, WS_OCAT); bf16* OCATB = PWS(bf16, WS_U);
        { __syncthreads(); float* LSE = PWS(float, WS_LSE);
          for (int u = C.bid; u < BATCH * 12 * 16; u += C.G) { const int head = u % 12, rest = u / 12, bb = rest >> 4, blk = rest & 15, gi = head >> 2, dd = 1 << (2 * gi);
              const int nblk = 16 >> (2 * gi), res = blk / nblk, m0 = (blk % nblk) * 256;
              const fa::Ids I = fa::make_ids_op(C.wave, fresh_lane()); fa::dil_unit(PROJ, OCAT, LSE, bb, head, dd, res, m0, C.lds + RING_OFF, I); }
          for (int u = C.bid; u < BATCH * 8 * 16; u += C.G) { const fa::Ids I = fa::make_ids_op(C.wave, fresh_lane()); fa::sb_unit(PROJ, OCAT, u >> 7, (u >> 4) & 7, (u & 15) * 256, C.lds + RING_OFF, I); } }
        __syncthreads();
        for (int it = C.gw; it < BATCH * SEQ * 4; it += C.ngw) dil_item(PROJ, OCATB, it, QS, PS, lane);
        for (int it = C.gw; it < BATCH * SEQ * 8; it += C.ngw) sb_item(PROJ, OCATB, it, QS, PS, lane);
        SEAM(2); }
    if (IN(3)) { CTX();
        const int lane = C.lane; const bf16* PROJ = PWS(bf16, WS_PROJ); const float* KC = PWS(float, WS_KC); float* OCMP = PWS(float, WS_OCMP); unsigned long long* SEL = PWS(unsigned long long, WS_SEL);
        for (int it = C.gw; it < BATCH * 2 * SEQ; it += C.ngw) cmp_item(PROJ, KC, OCMP, SEL, it, QS, PS, lane);
        { __syncthreads();
          for (int u = C.bid; u < 64; u += C.G) { const fa::Ids I = fa::make_ids_op(C.wave, fresh_lane()); fa::cmp_unit(PROJ, KC, PWS(float, WS_X), PWS(unsigned long long, WS_SEL) + 32768, (u >> 1) & 1, u & 1, (15 - (u >> 2)) * 256, C.lds + RING_OFF, I); } }
        SEAM(3); }
    if (IN(4)) { CTX();
        const int lane = C.lane; const bf16* PROJ = PWS(bf16, WS_PROJ); const float* OCMP = PWS(float, WS_OCMP); const unsigned long long* SEL = PWS(unsigned long long, WS_SEL); bf16* OCAT = PWS(bf16, WS_OCAT); bf16* OCATB = PWS(bf16, WS_U);
        { const float* LSE = PWS(float, WS_LSE); for (int it = C.gw; it < MTOK * 4; it += C.ngw) fa::dil_fixup(OCAT, LSE, it, lane); }
        { __syncthreads(); float* ACC = PWS(float, WS_X);
          for (int k = 0; ; ++k) { const int u = k * C.G + ((k & 1) ? C.G - 1 - C.bid : C.bid); if (u >= BATCH * 12 * 16) break;
              const fa::Ids I = fa::make_ids_op(C.wave, fresh_lane()); const int blk = 15 - u / 24, bh = u % 24; const bf16* PROJ_ = PROJ; const bf16* KVC_ = PWS(bf16, WS_KVC); const unsigned long long* SEL_ = PWS(unsigned long long, WS_SEL) + 32768; float* ACC_ = ACC; bf16* OCAT_ = OCAT; asm volatile("" : "+s"(PROJ_), "+s"(SEL_), "+s"(ACC_), "+s"(OCAT_), "+s"(KVC_));
              fa::nsa_unit(PROJ_, KVC_, SEL_, ACC_, OCAT_, bh / 12, bh % 12, blk * 256, C.lds + RING_OFF, I); } }
        __syncthreads();
        for (int it = C.gw; it < BATCH * SEQ * 12; it += C.ngw) nsa_item(PROJ, PWS(bf16, WS_KVC), OCMP, SEL, OCATB, it, QS, PS, lane);
        SEAM(4); }
    if (IN(5)) { CTX();
        const bf16* OCAT = PWS(bf16, WS_OCAT); const bf16* OCATB = PWS(bf16, WS_U); float* out = (float*)rd_ptr(F, PT_OUT);
        constexpr int c_lo = PROBE_SEC == 1 ? 0 : PROBE_SEC == 2 ? 1536 : 3072, c_hi = PROBE_SEC == 1 ? 1536 : PROBE_SEC == 2 ? 3072 : 4096;
        for (size_t e = (size_t)C.gw * 64 + C.lane; e < (size_t)MTOK * DM; e += (size_t)C.ngw * 64) { const int col = (int)(e & (DM - 1));
            out[e] = (col >= c_lo && col < c_hi) ? (float)PROBE_C * (bf2f(OCAT[e]) - bf2f(OCATB[e])) : 0.f; } }
}
#endif
template <int L> __device__ __forceinline__ void layer_phases(const Frame& F) {
    constexpr int pb = 1 + 9 * L;
        if (IN(pb + 0)) {
            CTX();
            pg8::Gemm g{PWS(bf16, WS_H), PWS(bf16, WS_WIN) + (size_t)L * NP * DM, MTOK, NP, DM};
            pg8::EpiProj E{PWS(bf16, WS_PROJ), NP, PWS(float, WS_COS), PWS(float, WS_SIN), SEQ, PWS(float, WS_SS) + (size_t)(2 * L) * 2 * MTOK, PWS(bf16, WS_KVC), MTOK, 0};
#if SPLIT_INPROJ
            pg8::MapOrder<1> S; S.init(MTOK, NP - 768, C.G, C.bid); pg8::gemm_phase<pg8::EpiProj, pg8::MapOrder<1>, true, true>(C.lds + RING_OFF, g, S, E, C.wave);
#else
            pg8::StaticOrder S; S.init(MTOK, NP, C.G, C.bid); pg8::gemm_phase<pg8::EpiProj, pg8::StaticOrder, true, true>(C.lds + RING_OFF, g, S, E, C.wave);
#endif
            SEAM(pb + 0);
        }
        if (IN(pb + 1)) {
            CTX();
            const int ngemm = (SPLIT_INPROJ && C.G > 96) ? 96 : 0;
#if SPLIT_INPROJ
            {   pg8::Gemm g{PWS(bf16, WS_H), PWS(bf16, WS_WIN) + (size_t)L * NP * DM, MTOK, NP, DM}; pg8::MapOrder<2> S; S.init(MTOK, 768, ngemm ? ngemm : C.G, C.bid);
                pg8::EpiProj E{PWS(bf16, WS_PROJ), NP, PWS(float, WS_COS), PWS(float, WS_SIN), SEQ, PWS(float, WS_SS) + (size_t)(2 * L) * 2 * MTOK, PWS(bf16, WS_KVC), MTOK, 0};
                pg8::gemm_phase<pg8::EpiProj, pg8::MapOrder<2>, true, true>(C.lds + RING_OFF, g, S, E, C.wave); }
#endif
            {
                const bf16* PROJ = PWS(bf16, WS_PROJ); bf16* OCAT = PWS(bf16, WS_OCAT); float* LSE = PWS(float, WS_LSE);
                const bf16* W1t = PWS(bf16, WS_W1T) + (size_t)L * 2 * 256 * 8192; const float* PEP = PWS(float, WS_PEP) + (size_t)L * 2 * 2 * 256; float* KC = PWS(float, WS_KC);
                int cleft = DEFER_CONV; asm volatile("" : "+s"(cleft));
                for (;;) {
                    if (C.wave == 0 && fresh_lane() == 0) F.MISC[52] = __hip_atomic_fetch_add(PWS(unsigned, WS_CTL) + 250000 + 64 * L, 1u, __ATOMIC_RELAXED, __HIP_MEMORY_SCOPE_AGENT);
                    __syncthreads(); const int v = (int)__builtin_amdgcn_readfirstlane((int)F.MISC[52]); __syncthreads();
                    if (v >= 128 + 256 + 64 + 384) break;
                    const fa::Ids I = fa::make_ids_op(C.wave, fresh_lane());
                    unsigned* done = PWS(unsigned, WS_CTL) + 252000 + 64 * L;
                    if (v < 128) fa::compress_unit(PROJ, W1t, PEP, PIN((v >> 6) ? 12 : 10) + (size_t)L * 256 * 128, KC, v, C.lds + RING_OFF, I, done);
                    else if (v < 384) { const int u = v - 128; fa::sb_unit(PROJ, OCAT, u >> 7, (u >> 4) & 7, (u & 15) * 256, C.lds + RING_OFF, I); }
                    else if (v < 448) { const int u = v - 384;
                        if (C.wave == 0) { unsigned sp = 0u;
                            while ((unsigned)__builtin_amdgcn_readfirstlane((int)__hip_atomic_load(done, __ATOMIC_RELAXED, __HIP_MEMORY_SCOPE_AGENT)) < 128u) { __builtin_amdgcn_s_sleep(4); if (++sp > (1u << 22)) break; }
                            __builtin_amdgcn_fence(__ATOMIC_ACQUIRE, "agent"); asm volatile("s_waitcnt vmcnt(0)" ::: "memory"); }
                        __syncthreads();
                        fa::cmp_unit(PROJ, KC, PWS(float, WS_OCMP), PWS(unsigned long long, WS_SEL), (u >> 1) & 1, u & 1, (15 - (u >> 2)) * 256, C.lds + RING_OFF, I); }
                    else { const int u = v - 448, head = u % 12, rest = u / 12, bb = rest >> 4, blk = rest & 15, gi = head >> 2, dd = 1 << (2 * gi);
                        const int nblk = 16 >> (2 * gi), res = blk / nblk, m0 = (blk % nblk) * 256;
                        fa::dil_unit(PROJ, OCAT, LSE, bb, head, dd, res, m0, C.lds + RING_OFF, I); }
                    if (DEFER_CONV) {
#pragma unroll 1
                        for (int p_ = 0; p_ < CVQ_P0 && cleft; ++p_) cleft = conv_chunk<1>(F, C, 2 * L) ? 1 : 0; } }
                if (DEFER_CONV) {
#pragma unroll 1
                    while (cleft) cleft = conv_chunk<1>(F, C, 2 * L) ? 1 : 0; } }
            SEAM(pb + 1);
        }
#if !USE_FA_NSA
        if (IN(pb + 2)) {
            CTX();
            const int lane = C.lane; const bf16* PROJ = PWS(bf16, WS_PROJ); const float* KC = PWS(float, WS_KC); float* OCMP = PWS(float, WS_OCMP); unsigned long long* SEL = PWS(unsigned long long, WS_SEL);
#if !USE_FA_NSA
            for (int it = C.gw; it < BATCH * 2 * SEQ; it += C.ngw) cmp_item(PROJ, KC, OCMP, SEL, it, QS, PS, lane);
#endif
            SEAM(pb + 2);
        }
#endif
        if (IN(pb + 3)) {
            CTX();
            const int lane = C.lane; const bf16* PROJ = PWS(bf16, WS_PROJ); const float* OCMP = PWS(float, WS_OCMP); const unsigned long long* SEL = PWS(unsigned long long, WS_SEL); bf16* OCAT = PWS(bf16, WS_OCAT);
#if USE_FA_DIL
            { const float* LSE = PWS(float, WS_LSE); for (int it = C.gw; it < MTOK * 4; it += C.ngw) fa::dil_fixup(OCAT, LSE, it, lane); }
#endif
#if USE_FA_NSA
            { __syncthreads(); const fa::Ids I = fa::make_ids(C.wave, C.lane); const unsigned long long* SELp = PWS(unsigned long long, WS_SEL); float* ACC = PWS(float, WS_OCMP); const bf16* KVCp = PWS(bf16, WS_KVC);
              { const int xq = (int)(xb_xcc_id() & 7u); int cleft = DEFER_CONV; asm volatile("" : "+s"(cleft));
                for (int qi = 0; qi < 8; ++qi) { const int q = (xq + qi) & 7;
                  for (;;) {
                      if (C.wave == 0 && fresh_lane() == 0) F.MISC[52] = __hip_atomic_fetch_add(PWS(unsigned, WS_CTL) + 240000 + 64 * (L * 8 + q), 1u, __ATOMIC_RELAXED, __HIP_MEMORY_SCOPE_AGENT);
                      __syncthreads(); const int e = (int)__builtin_amdgcn_readfirstlane((int)F.MISC[52]); __syncthreads();
                      if (e >= 48) break;
                      const int combo = (e / 6) * 8 + q, blk = 15 - (combo >> 2), bg = combo & 3, hq = (bg & 1) * 6 + e % 6, bq = bg >> 1;
                      const fa::Ids I = fa::make_ids_op(C.wave, fresh_lane());
                      const bf16* PROJ_ = PROJ; const unsigned long long* SEL_ = SELp; float* ACC_ = ACC; bf16* OCAT_ = OCAT; const bf16* KVC_ = KVCp; asm volatile("" : "+s"(PROJ_), "+s"(SEL_), "+s"(ACC_), "+s"(OCAT_), "+s"(KVC_));
                      fa::nsa_unit(PROJ_, KVC_, SEL_, ACC_, OCAT_, bq, hq, blk * 256, C.lds + RING_OFF, I, F.MISC);
                      if (DEFER_CONV) {
#pragma unroll 1
                          for (int p_ = 0; p_ < CVQ_P1 && cleft; ++p_) cleft = conv_chunk<4>(F, C, 2 * L + 1) ? 1 : 0; } } }
                if (DEFER_CONV) {
#pragma unroll 1
                    while (cleft) cleft = conv_chunk<4>(F, C, 2 * L + 1) ? 1 : 0; } } }
#else
            for (int it = C.gw; it < BATCH * SEQ * 12; it += C.ngw) nsa_item(PROJ, PWS(bf16, WS_KVC), OCMP, SEL, OCAT, it, QS, PS, lane);
#endif

            SEAM(pb + 3);
        }
        if (IN(pb + 4)) {
            CTX();
            pg8::Gemm g{PWS(bf16, WS_OCAT), PWS(bf16, WS_WOUT) + (size_t)L * DM * DM, MTOK, DM, DM}; pg8::StaticOrder S; S.init(MTOK, DM, C.G, C.bid);
            { float* KC = PWS(float, WS_KC); for (int e = C.gw * 64 + C.lane; e < 2 * 2 * 256 * 128; e += C.ngw * 64) KC[e] = 0.f; }
            pg8::EpiResidB E{PWS(bf16, WS_H), DM, PWS(float, WS_SS) + (size_t)(2 * L + 1) * 2 * MTOK, L == 0 ? PIN(0) : nullptr};
            pg8::gemm_phase<pg8::EpiResidB, pg8::StaticOrder, true, true>(C.lds + RING_OFF, g, S, E, C.wave);

            SEAM(pb + 4);

        }
        if (IN(pb + 6)) {
            CTX();
            pg8::Gemm g{PWS(bf16, WS_H), PWS(bf16, WS_WUP) + (size_t)L * DFF * DM, MTOK, DFF, DM}; pg8::StaticOrder S; S.init(MTOK, DFF, C.G, C.bid);
            pg8::EpiRelu2 E{PWS(bf16, WS_U), DFF, PWS(float, WS_SS) + (size_t)(2 * L + 1) * 2 * MTOK};
            for (int rep_ = 0; rep_ < NREP(6); ++rep_) pg8::gemm_phase<pg8::EpiRelu2, pg8::StaticOrder, true, true>(C.lds + RING_OFF, g, S, E, C.wave);

            SEAM(pb + 6);

        }
        if (IN(pb + 7)) {
            CTX();
            pg8::Gemm g{PWS(bf16, WS_U), PWS(bf16, WS_WDN) + (size_t)L * DM * DFF, MTOK, DM, DFF}; pg8::StaticOrder S; S.init(MTOK, DM, C.G, C.bid);
            pg8::EpiResidB E{PWS(bf16, WS_H), DM, PWS(float, WS_SS) + (size_t)(2 * L + 2) * 2 * MTOK, nullptr};
            pg8::gemm_phase<pg8::EpiResidB, pg8::StaticOrder, true, true>(C.lds + RING_OFF, g, S, E, C.wave);

            SEAM(pb + 7);

        }
        if (L + 1 == DEPTH && IN(pb + 8)) {
            CTX();
            norm_phase_b(C, PWS(bf16, WS_H), PIN(13), (float*)rd_ptr(F, PT_OUT));
            SEAM(pb + 8);
        }
}

struct Args { const float* in[14]; float* out; unsigned char* ws; int ph_lo, ph_hi; };
__global__ void __launch_bounds__(NWAVES * 64, 2) mega_fwd(Args args) {
    extern __shared__ __attribute__((aligned(16))) unsigned char lds[];
    Frame F;
    F.lds = (LAS unsigned char*)lds; F.MISC = (volatile LAS unsigned*)(F.lds + MISC_OFF);
    F.wave = __builtin_amdgcn_readfirstlane((int)(threadIdx.x >> 6));
    if (threadIdx.x < 64) ((LAS unsigned*)(F.lds + MISC_OFF))[threadIdx.x] = 0u;
    __syncthreads();
    if (threadIdx.x == 0) {
#pragma unroll
        for (int k = 0; k < 16; ++k) { const unsigned long long p = k < 14 ? (unsigned long long)args.in[k < 14 ? k : 0] : (k == 14 ? (unsigned long long)args.out : (unsigned long long)args.ws);
            F.MISC[16 + 2 * k] = (unsigned)p; F.MISC[17 + 2 * k] = (unsigned)(p >> 32); } }
    if (threadIdx.x == 0) { F.MISC[53] = (unsigned)args.ph_lo; F.MISC[54] = (unsigned)args.ph_hi; }
    __syncthreads();
    (void)xcd_barrier_post(PWS(unsigned, WS_CTL) + CW_BAR + PH_LO() * XCD_BAR_WORDS, F.MISC + 8);

    if (PROBE_T && threadIdx.x == 0) { const unsigned long long now_ = wall_clock64(); F.MISC[48] = (unsigned)now_; F.MISC[49] = (unsigned)(now_ >> 32); F.MISC[50] = 0u; }
#ifndef NO_PRO
    if (IN(0)) { CTX(); p0_prologue(F, C); SEAM(0); }
#endif
#if PROBE_SEC
    if (threadIdx.x == 0) F.MISC[54] = 2u; __syncthreads();
    layer_phases<0>(F);
    __syncthreads(); if (threadIdx.x == 0) F.MISC[54] = (unsigned)args.ph_hi; __syncthreads();
    probe_phases(F);
#else
    layer_phases<0>(F);
    layer_phases<1>(F);
#endif
#if PROBE_N
    { XcdBarrier b_; b_.bar = PWS(unsigned, WS_CTL) + CW_BAR + PH_LO() * XCD_BAR_WORDS; b_.x = xb_xcc_id(); b_.st = F.MISC + 8; xcd_barrier(b_);
      if (blockIdx.x == 0 && threadIdx.x == 0) { const unsigned long long* tsb = (const unsigned long long*)(rd_ptr(F, PT_WS)) + TS_BASE + 600;
          const unsigned long long v = __hip_atomic_load(tsb + (PROBE_N - 1), __ATOMIC_RELAXED, __HIP_MEMORY_SCOPE_AGENT) / gridDim.x;
          const unsigned long long t0 = wall_clock64(); while (wall_clock64() - t0 < (unsigned long long)PROBE_K * v) __builtin_amdgcn_s_sleep(8); } }
#endif
#if PROBE_T
    { TSTAMP(); XcdBarrier b_; b_.bar = PWS(unsigned, WS_CTL) + CW_BAR + PH_LO() * XCD_BAR_WORDS; b_.x = xb_xcc_id(); b_.st = F.MISC + 8; xcd_barrier(b_);
      if (blockIdx.x == 0 && threadIdx.x == 0) { const unsigned long long* tsb = (const unsigned long long*)(rd_ptr(F, PT_WS)) + TS_BASE; unsigned long long v = 0;
          if (PROBE_T == 999) { const int ns_ = (int)F.MISC[50]; for (int s = 1; s < ns_; s += 2) v += __hip_atomic_load(tsb + s, __ATOMIC_RELAXED, __HIP_MEMORY_SCOPE_AGENT) / gridDim.x; }
          else if (PROBE_T > 100) v = __hip_atomic_load(tsb + 256 + (PROBE_T - 101), __ATOMIC_RELAXED, __HIP_MEMORY_SCOPE_AGENT);
          else v = __hip_atomic_load(tsb + (PROBE_T - 1), __ATOMIC_RELAXED, __HIP_MEMORY_SCOPE_AGENT) / gridDim.x;
          const unsigned long long t0 = wall_clock64(); while (wall_clock64() - t0 < (unsigned long long)PROBE_K * v) __builtin_amdgcn_s_sleep(8); } }
#endif
}

extern "C" void kernel_launch(void* const* d_in, const int* in_sizes, int n_in, void* d_out, int out_size, void* d_ws, size_t ws_size, hipStream_t stream) {
    static int grid = 0;
    if (grid == 0) {
        if (n_in != 14 || in_sizes[0] != MTOK * DM || out_size != MTOK * DM || ws_size < WS_END) {
            fprintf(stderr, "kernel_launch: unexpected shapes (n_in %d, in0 %d, out %d, ws %zu; need ws >= %zu); nothing launched\n", n_in, n_in > 0 ? in_sizes[0] : -1, out_size, ws_size, (size_t)WS_END); grid = -1; return; }
        int dev = 0, cus = 0, per_cu = 0;
        if (hipGetDevice(&dev) != hipSuccess || hipDeviceGetAttribute(&cus, hipDeviceAttributeMultiprocessorCount, dev) != hipSuccess) { fprintf(stderr, "kernel_launch: device query failed\n"); grid = -1; return; }
        if (hipFuncSetAttribute((const void*)mega_fwd, hipFuncAttributeMaxDynamicSharedMemorySize, LDS_BYTES) != hipSuccess) { fprintf(stderr, "kernel_launch: hipFuncSetAttribute failed\n"); grid = -1; return; }
        if (hipOccupancyMaxActiveBlocksPerMultiprocessor(&per_cu, (const void*)mega_fwd, NWAVES * 64, LDS_BYTES) != hipSuccess || per_cu < 1)
            fprintf(stderr, "kernel_launch: note: occupancy query reports %d workgroups per CU\n", per_cu);
        (void)hipGetLastError();
        grid = cus;
    }
    if (grid < 0) return;
    if (hipMemsetAsync((char*)d_ws + WS_CTL, 0, CTL_ZERO_BYTES, stream) != hipSuccess) { fprintf(stderr, "kernel_launch: memset failed\n"); return; }
    Args a{};
    for (int i = 0; i < 14; ++i) a.in[i] = (const float*)d_in[i];
    a.out = (float*)d_out; a.ws = (unsigned char*)d_ws;
#if PROBE_SEC
    a.ph_lo = 0; a.ph_hi = 6;
    hipLaunchKernelGGL(mega_fwd, dim3(grid), dim3(NWAVES * 64), LDS_BYTES, stream, a);
#elif MK_ONE_LAUNCH
    a.ph_lo = 0; a.ph_hi = NPH;
    hipLaunchKernelGGL(mega_fwd, dim3(grid), dim3(NWAVES * 64), LDS_BYTES, stream, a);
#else
    for (int ph = 0; ph < NPH; ++ph) { a.ph_lo = ph; a.ph_hi = ph + 1;
        hipLaunchKernelGGL(mega_fwd, dim3(grid), dim3(NWAVES * 64), LDS_BYTES, stream, a); }
#endif
    const hipError_t le = hipPeekAtLastError();
    if (le != hipSuccess) fprintf(stderr, "kernel_launch: launch failed: %s\n", hipGetErrorName(le));
}
```
